# Optimizing an MI355X kernel written in HIP

```python
import math
import jax, jax.numpy as jnp
from jax import lax
import numpy as np

D_MODEL = 1024
BATCH = 8
SEQ = 8192
DEPTH = 4
DEC_BATCH = 4
DEC_SEQ = 4096
PAST_LEN = 128

HEAD_DIM = 64
GRID_W = 64
Q_BLOCK = 128
EPS = 1e-6
A_HEADS = 8
A_KV_HEADS = 2
AXIAL_THETA = 10000.0
B_HEADS = 4
B_V_DIM = 2 * HEAD_DIM
C_HEADS = 16
C_KV_HEADS = 4
WINDOW = 128
ROPE_THETA = 500000.0
ROPE_DIM = HEAD_DIM // 4
FFN_HIDDEN = -(-8 * D_MODEL // (3 * 256)) * 256

A_Q = A_HEADS * HEAD_DIM
A_KV = A_KV_HEADS * HEAD_DIM
B_QK = B_HEADS * 2 * HEAD_DIM
B_V = B_HEADS * B_V_DIM
EVEN_IN = A_Q + 2 * A_KV + 2 * B_QK + B_V
EVEN_OUT = A_Q + B_V
C_Q = C_HEADS * HEAD_DIM
C_KV = C_KV_HEADS * HEAD_DIM
ODD_IN = C_Q + 2 * C_KV
ODD_OUT = C_Q
N_EVEN = (DEPTH + 1) // 2
N_ODD = DEPTH // 2

kernel_name = "hybrid_axial_diff_window_encoder"


def rms_norm(x, g):
    xf = x.astype(jnp.float32)
    y = xf * lax.rsqrt(jnp.mean(xf * xf, axis=-1, keepdims=True) + EPS)
    return (y * g.astype(jnp.float32)).astype(x.dtype)


def rms_norm_nogain(x):
    xf = x.astype(jnp.float32)
    return (xf * lax.rsqrt(jnp.mean(xf * xf, axis=-1, keepdims=True) + EPS)).astype(x.dtype)


def rope_table(pos, dim, theta):
    inv = theta ** (-jnp.arange(0, dim, 2, dtype=jnp.float32) / dim)
    ang = pos.astype(jnp.float32)[:, None] * inv[None, :]
    return jnp.cos(ang), jnp.sin(ang)


def rotate(x, cos, sin):
    xf = x.astype(jnp.float32)
    half = xf.shape[-1] // 2
    x1, x2 = xf[..., :half], xf[..., half:]
    c, s = cos[:, None, :], sin[:, None, :]
    return jnp.concatenate([x1 * c - x2 * s, x2 * c + x1 * s], axis=-1).astype(x.dtype)


def partial_rope(x, cos, sin):
    return jnp.concatenate([rotate(x[..., :ROPE_DIM], cos, sin), x[..., ROPE_DIM:]], axis=-1)


def axial_rope(x, row_cos, row_sin, col_cos, col_sin):
    half = HEAD_DIM // 2
    return jnp.concatenate([rotate(x[..., :half], row_cos, row_sin),
                            rotate(x[..., half:], col_cos, col_sin)], axis=-1)


def to_blocks(q):
    B, S = q.shape[0], q.shape[1]
    qb = q.reshape((B, S // Q_BLOCK, Q_BLOCK) + q.shape[2:])
    return jnp.moveaxis(qb, 1, 0)


def from_blocks(o):
    o = jnp.moveaxis(o, 0, 1)
    return o.reshape((o.shape[0], o.shape[1] * o.shape[2]) + o.shape[3:])


def dense_gqa_blocks(q, k, v):
    B, S, Hq, d = q.shape
    Hkv = k.shape[2]
    G = Hq // Hkv
    scale = d ** -0.5
    qb = to_blocks(q.reshape(B, S, Hkv, G, d))

    def one_block(qi):
        s = jnp.einsum('bqhgd,bkhd->bhgqk', qi, k).astype(jnp.float32) * scale
        p = jax.nn.softmax(s, axis=-1).astype(v.dtype)
        return jnp.einsum('bhgqk,bkhd->bqhgd', p, v)

    return from_blocks(lax.map(one_block, qb)).reshape(B, S, Hq, d)


def diff_attention_blocks(qs, ks, v, lam):
    d = qs.shape[-1]
    scale = d ** -0.5
    qb = to_blocks(qs)

    def one_block(qi):
        s = jnp.einsum('bqmhd,bkmhd->bmhqk', qi, ks).astype(jnp.float32) * scale
        p = jax.nn.softmax(s, axis=-1)
        a = (p[:, 0] - lam * p[:, 1]).astype(v.dtype)
        return jnp.einsum('bhqk,bkhe->bqhe', a, v)

    return from_blocks(lax.map(one_block, qb))


def window_gqa_sink(q, k, v, sink):
    B, S, Hq, d = q.shape
    Hkv = k.shape[2]
    G = Hq // Hkv
    nb = S // Q_BLOCK
    KB = Q_BLOCK + 2 * WINDOW
    scale = d ** -0.5
    kp = jnp.pad(k, ((0, 0), (WINDOW, WINDOW), (0, 0), (0, 0)))
    vp = jnp.pad(v, ((0, 0), (WINDOW, WINDOW), (0, 0), (0, 0)))
    qb = to_blocks(q.reshape(B, S, Hkv, G, d))
    rel = jnp.arange(KB)[None, :] - WINDOW - jnp.arange(Q_BLOCK)[:, None]
    band = jnp.abs(rel) <= WINDOW
    sink_g = sink.reshape(Hkv, G).astype(jnp.float32)

    def one_block(args):
        i, qi = args
        start = i * Q_BLOCK
        ki = lax.dynamic_slice_in_dim(kp, start, KB, axis=1)
        vi = lax.dynamic_slice_in_dim(vp, start, KB, axis=1)
        key_pos = start - WINDOW + jnp.arange(KB)
        valid = band & ((key_pos >= 0) & (key_pos < S))[None, :]
        s = jnp.einsum('bqhgd,bkhd->bhgqk', qi, ki).astype(jnp.float32) * scale
        s = jnp.where(valid, s, -jnp.inf)
        sink_col = jnp.broadcast_to(sink_g[None, :, :, None, None], s.shape[:-1] + (1,))
        p = jax.nn.softmax(jnp.concatenate([s, sink_col], axis=-1), axis=-1)[..., :KB]
        return jnp.einsum('bhgqk,bkhd->bqhgd', p.astype(v.dtype), vi)

    o = lax.map(one_block, (jnp.arange(nb), qb))
    return from_blocks(o).reshape(B, S, Hq, d)


def even_mixer(h, w_in, w_out, qk_norm_a, diff_lambda, lam_init, axial, rope):
    B, S, _ = h.shape
    proj = h @ w_in
    qa, ka, va, qbd, kbd, vbd = jnp.split(
        proj, [A_Q, A_Q + A_KV, A_Q + 2 * A_KV, A_Q + 2 * A_KV + B_QK, A_Q + 2 * A_KV + 2 * B_QK], axis=-1)
    qa = rms_norm(qa.reshape(B, S, A_HEADS, HEAD_DIM), qk_norm_a[0])
    ka = rms_norm(ka.reshape(B, S, A_KV_HEADS, HEAD_DIM), qk_norm_a[1])
    va = va.reshape(B, S, A_KV_HEADS, HEAD_DIM)
    qa = axial_rope(qa, *axial)
    ka = axial_rope(ka, *axial)
    oa = dense_gqa_blocks(qa, ka, va).reshape(B, S, A_Q)
    cos, sin = rope
    qbd = partial_rope(qbd.reshape(B, S, B_HEADS * 2, HEAD_DIM), cos, sin)
    kbd = partial_rope(kbd.reshape(B, S, B_HEADS * 2, HEAD_DIM), cos, sin)
    qs = qbd.reshape(B, S, B_HEADS, 2, HEAD_DIM).swapaxes(2, 3)
    ks = kbd.reshape(B, S, B_HEADS, 2, HEAD_DIM).swapaxes(2, 3)
    vbd = vbd.reshape(B, S, B_HEADS, B_V_DIM)
    lf = diff_lambda.astype(jnp.float32)
    lam = jnp.exp(jnp.sum(lf[0] * lf[1])) - jnp.exp(jnp.sum(lf[2] * lf[3])) + lam_init
    ob = diff_attention_blocks(qs, ks, vbd, lam)
    ob = (rms_norm_nogain(ob) * (1.0 - lam_init)).reshape(B, S, B_V)
    return jnp.concatenate([oa, ob], axis=-1) @ w_out


def odd_mixer(h, w_in, w_out, sink, rope):
    B, S, _ = h.shape
    cos, sin = rope
    q, k, v = jnp.split(h @ w_in, [C_Q, C_Q + C_KV], axis=-1)
    q = partial_rope(q.reshape(B, S, C_HEADS, HEAD_DIM), cos, sin)
    k = partial_rope(k.reshape(B, S, C_KV_HEADS, HEAD_DIM), cos, sin)
    v = v.reshape(B, S, C_KV_HEADS, HEAD_DIM)
    o = window_gqa_sink(q, k, v, sink).reshape(B, S, ODD_OUT)
    return o @ w_out


def swiglu(h, w_gate_up, w_down):
    g, u = jnp.split(h @ w_gate_up, 2, axis=-1)
    return (jax.nn.silu(g) * u) @ w_down


def trunk(x, w_in_even, w_out_even, qk_norm_a, diff_lambda, w_in_odd, w_out_odd, sink_c,
          w_gate_up, w_down, norm_mix_pre, norm_mix_post, norm_ffn_pre, norm_ffn_post):
    S = x.shape[1]
    rows = S // GRID_W
    t_row = jnp.broadcast_to(jnp.arange(rows)[:, None], (rows, GRID_W)).reshape(-1)
    t_col = jnp.broadcast_to(jnp.arange(GRID_W)[None, :], (rows, GRID_W)).reshape(-1)
    row_cos, row_sin = rope_table(t_row, HEAD_DIM // 2, AXIAL_THETA)
    col_cos, col_sin = rope_table(t_col, HEAD_DIM // 2, AXIAL_THETA)
    axial = (row_cos, row_sin, col_cos, col_sin)
    rope = rope_table(jnp.arange(S), ROPE_DIM, ROPE_THETA)
    for l in range(DEPTH):
        h = rms_norm(x, norm_mix_pre[l])
        if l % 2 == 0:
            lam_init = 0.8 - 0.6 * math.exp(-0.3 * l)
            m = even_mixer(h, w_in_even[l // 2], w_out_even[l // 2], qk_norm_a[l // 2],
                           diff_lambda[l // 2], lam_init, axial, rope)
        else:
            m = odd_mixer(h, w_in_odd[l // 2], w_out_odd[l // 2], sink_c[l // 2], rope)
        x = x + rms_norm(m, norm_mix_post[l])
        h = rms_norm(x, norm_ffn_pre[l])
        x = x + rms_norm(swiglu(h, w_gate_up[l], w_down[l]), norm_ffn_post[l])
    return x


def setup_inputs(seed: int = 0) -> dict:
    key = jax.random.key(seed)
    ks = jax.random.split(key, 16)
    f32 = jnp.float32

    def nrm(k, shape, scale):
        return jax.random.normal(k, shape, f32) * scale

    def gain(k, shape):
        return jnp.ones(shape, f32) + 0.05 * jax.random.normal(k, shape, f32)

    return {
        "x_prompt": nrm(ks[0], (BATCH, SEQ, D_MODEL), 1.0),
        "x_sample": nrm(ks[1], (DEC_BATCH, DEC_SEQ, D_MODEL), 1.0),
        "w_in_even": nrm(ks[2], (N_EVEN, D_MODEL, EVEN_IN), D_MODEL ** -0.5),
        "w_out_even": nrm(ks[3], (N_EVEN, EVEN_OUT, D_MODEL), EVEN_OUT ** -0.5),
        "qk_norm_a": gain(ks[4], (N_EVEN, 2, HEAD_DIM)),
        "diff_lambda": nrm(ks[5], (N_EVEN, 4, HEAD_DIM), 0.1),
        "w_in_odd": nrm(ks[6], (N_ODD, D_MODEL, ODD_IN), D_MODEL ** -0.5),
        "w_out_odd": nrm(ks[7], (N_ODD, ODD_OUT, D_MODEL), ODD_OUT ** -0.5),
        "sink_c": nrm(ks[8], (N_ODD, C_HEADS), 0.5),
        "w_gate_up": nrm(ks[9], (DEPTH, D_MODEL, 2 * FFN_HIDDEN), D_MODEL ** -0.5),
        "w_down": nrm(ks[10], (DEPTH, FFN_HIDDEN, D_MODEL), FFN_HIDDEN ** -0.5),
        "norm_mix_pre": gain(ks[11], (DEPTH, D_MODEL)),
        "norm_mix_post": gain(ks[12], (DEPTH, D_MODEL)),
        "norm_ffn_pre": gain(ks[13], (DEPTH, D_MODEL)),
        "norm_ffn_post": gain(ks[14], (DEPTH, D_MODEL)),
    }


def reference(x_prompt, x_sample, w_in_even, w_out_even, qk_norm_a, diff_lambda, w_in_odd,
              w_out_odd, sink_c, w_gate_up, w_down, norm_mix_pre, norm_mix_post, norm_ffn_pre,
              norm_ffn_post):
    y_prompt = trunk(x_prompt, w_in_even, w_out_even, qk_norm_a, diff_lambda, w_in_odd, w_out_odd,
                     sink_c, w_gate_up, w_down, norm_mix_pre, norm_mix_post, norm_ffn_pre, norm_ffn_post)
    y_sample = trunk(x_sample, w_in_even, w_out_even, qk_norm_a, diff_lambda, w_in_odd, w_out_odd,
                     sink_c, w_gate_up, w_down, norm_mix_pre, norm_mix_post, norm_ffn_pre, norm_ffn_post)
    return (y_prompt, y_sample)
```

```cpp
#include <hip/hip_runtime.h>
#include <cstdio>
#include <cstdint>
namespace pg8 {
#define PG8_LAS __attribute__((address_space(3)))
typedef unsigned short bf16_t;
typedef short bf16x8 __attribute__((ext_vector_type(8)));
typedef float f32x4 __attribute__((ext_vector_type(4)));
typedef unsigned u32x4 __attribute__((ext_vector_type(4)));
constexpr int BM = 256, BK = 64, HALF = 128, HTB = HALF * BK * 2  , STAGE_BYTES = 8 * HTB, NXCD = 8, WGM = 8;

__host__ __device__ __forceinline__ int lds_byte(int r, int c) { const int st = (r >> 4) * 2 + (c >> 5), rr = r & 15, cc = c & 31, ob = rr * 64 + cc * 2; return st * 1024 + (ob ^ (((ob >> 9) & 1) << 5)); }
__host__ __device__ __forceinline__ void stage_rc(int b, int& R, int& C) { const int st = b / 1024, sb = b % 1024, swz = sb ^ (((sb >> 9) & 1) << 5); R = (st >> 1) * 16 + swz / 64; C = (st & 1) * 32 + (swz % 64) / 2; }
__host__ __device__ __forceinline__ int perm32(int rho) { const int n = rho >> 4, i = rho & 15; return 8 * (i >> 2) + 4 * n + (i & 3); }

struct Unit { int pm, pn; };
struct Gemm { const bf16_t* A; const bf16_t* Bt; int M, N, K; };

struct StaticOrder {
    int nM, nN, nwg, G, c;
    __host__ __device__ void init(int M, int N, int G_, int c_) { nM = M / BM; nN = N / BM; nwg = nM * nN; G = G_; c = c_; }
    __host__ __device__ bool next(int i, Unit& u) const {
        const long L = (long)i * G + c; if (L >= nwg) return false;
        int wgid = (int)L; { const int q = nwg / NXCD, r = nwg % NXCD, xcd = wgid % NXCD, off = wgid / NXCD; wgid = (xcd < r ? xcd * (q + 1) : r * (q + 1) + (xcd - r) * q) + off; }
        const int nig = WGM * nN, gid = wgid / nig, fm = gid * WGM, gsz = (nM - fm) < WGM ? (nM - fm) : WGM;
        u.pm = fm + ((wgid % nig) % gsz); u.pn = (wgid % nig) / gsz; return true;
    }
    __device__ __forceinline__ void a_ready(const Unit&) const {}
    __device__ __forceinline__ void done(const Unit&) const {}
};

__device__ __forceinline__ unsigned cvt_pk_bf16(float lo, float hi) { unsigned r; asm volatile("v_cvt_pk_bf16_f32 %0, %1, %2" : "=v"(r) : "v"(lo), "v"(hi)); return r; }
typedef float f32x2 __attribute__((ext_vector_type(2)));
template <bool RSC> struct EpiBf16 {
    static constexpr bool PERM = true, AFTER_DRAIN = false, HAS_RS = RSC;
    bf16_t* O; int ldc; const float* rs;
    __device__ __forceinline__ void operator()(const f32x4 (&acc)[2][2][4][2], const Unit& u, int wr, int wc, int fr, int fq, const float (&rsv)[8]) const {
        const int row0 = u.pm * BM + wr * 64 + fr; const int col0 = u.pn * BM + wc * 32 + 8 * fq;
#pragma unroll
        for (int ai = 0; ai < 2; ++ai)
#pragma unroll
            for (int m = 0; m < 4; ++m) { bf16_t* rowp = O + (size_t)(row0 + ai * HALF + m * 16) * ldc + col0; const float sc = RSC ? rsv[4 * ai + m] : 1.f;
#pragma unroll
                for (int bj = 0; bj < 2; ++bj) { const f32x4 v0 = acc[ai][bj][m][0] * sc, v1 = acc[ai][bj][m][1] * sc;
                    u32x4 w; w.x = cvt_pk_bf16(v0[0], v0[1]); w.y = cvt_pk_bf16(v0[2], v0[3]); w.z = cvt_pk_bf16(v1[0], v1[1]); w.w = cvt_pk_bf16(v1[2], v1[3]);
                    *(u32x4*)(rowp + bj * HALF) = w; } }
    }
};
__device__ __forceinline__ float silu_mul(float g, float u) { const float e = __builtin_amdgcn_exp2f(g * -1.4426950408889634f); return g * __builtin_amdgcn_rcpf(1.0f + e) * u; }
struct EpiSwiGLU {
    static constexpr bool PERM = true, AFTER_DRAIN = false, HAS_RS = true;
    bf16_t* O; int ldc; const float* rs;
    __device__ __forceinline__ void operator()(const f32x4 (&acc)[2][2][4][2], const Unit& u, int wr, int wc, int fr, int fq, const float (&rsv)[8]) const {
        const int row0 = u.pm * BM + wr * 64 + fr; const int col0 = u.pn * HALF + wc * 32 + 8 * fq;
#pragma unroll
        for (int ai = 0; ai < 2; ++ai)
#pragma unroll
            for (int m = 0; m < 4; ++m) { bf16_t* rowp = O + (size_t)(row0 + ai * HALF + m * 16) * ldc + col0;
                const float sc = rsv[4 * ai + m];
                const f32x4 g0 = acc[ai][0][m][0] * sc, g1 = acc[ai][0][m][1] * sc, u0 = acc[ai][1][m][0] * sc, u1 = acc[ai][1][m][1] * sc;
                u32x4 w; w.x = cvt_pk_bf16(silu_mul(g0[0], u0[0]), silu_mul(g0[1], u0[1])); w.y = cvt_pk_bf16(silu_mul(g0[2], u0[2]), silu_mul(g0[3], u0[3]));
                w.z = cvt_pk_bf16(silu_mul(g1[0], u1[0]), silu_mul(g1[1], u1[1])); w.w = cvt_pk_bf16(silu_mul(g1[2], u1[2]), silu_mul(g1[3], u1[3]));
                *(u32x4*)rowp = w; }
    }
};

template <class Epi, class Sched, bool ALIGN_EPI = false, bool SP2 = false>
__device__ __forceinline__ void gemm_phase(PG8_LAS unsigned char* lds, const Gemm g, const Sched& S, const Epi& E) {
    int tid_ = threadIdx.x; asm volatile("" : "+v"(tid_));
    const int tid = tid_, wid = __builtin_amdgcn_readfirstlane(tid >> 6), lane = tid & 63, wr = wid >> 2, wc = wid & 3, fr = lane & 15, fq = lane >> 4;
    const int K = g.K, nt = K / BK;
    unsigned voffA[2], voffB[2];
#pragma unroll
    for (int i = 0; i < 2; ++i) { int R, C; stage_rc(tid * 16 + i * 8192, R, C); const int Rb = Epi::PERM ? ((R & ~31) + perm32(R & 31)) : R;
        voffA[i] = (unsigned)(R * K + C) * 2u; voffB[i] = (unsigned)(Rb * K + C) * 2u; }
    const size_t kstep = (size_t)(BK * 2);
    const size_t hstep = (size_t)HALF * K * 2;
    const size_t tstep = 2 * hstep;
    const unsigned ldsw = (unsigned)wid * 1024u;
    const int aoff = lds_byte(wr * 64 + fr, fq * 8), boff = lds_byte(wc * 32 + fr, fq * 8);
#define PG8_SA(b, h) (((b) * 2 + (h)) * HTB)
#define PG8_SB(b, h) ((4 + (b) * 2 + (h)) * HTB)
#define PG8_STAGE(bufoff, gbase, voff) do { _Pragma("unroll") for (int _i = 0; _i < 2; ++_i) \
        __builtin_amdgcn_global_load_lds((const unsigned*)((const char*)(gbase) + (voff)[_i]), (PG8_LAS unsigned*)(lds + (bufoff) + ldsw + _i * 8192), 16, 0, 0); } while (0)
#define PG8_LDA(dst, b, h) do { _Pragma("unroll") for (int m = 0; m < 4; ++m) _Pragma("unroll") for (int k = 0; k < 2; ++k) dst[m][k] = *(const PG8_LAS bf16x8*)(lds + PG8_SA(b, h) + aoff + m * 2048 + k * 1024); } while (0)
#define PG8_LDB(dst, b, h) do { _Pragma("unroll") for (int n = 0; n < 2; ++n) _Pragma("unroll") for (int k = 0; k < 2; ++k) dst[n][k] = *(const PG8_LAS bf16x8*)(lds + PG8_SB(b, h) + boff + n * 2048 + k * 1024); } while (0)
#define PG8_MMA(ai, bj, At, Bt) do { __builtin_amdgcn_s_setprio(1); _Pragma("unroll") for (int m = 0; m < 4; ++m) _Pragma("unroll") for (int n = 0; n < 2; ++n) _Pragma("unroll") for (int k = 0; k < 2; ++k) \
        acc[ai][bj][m][n] = __builtin_amdgcn_mfma_f32_16x16x32_bf16(Bt[n][k], At[m][k], acc[ai][bj][m][n], 0, 0, 0); __builtin_amdgcn_s_setprio(0); } while (0)
#define PG8_WAIT_V(n) asm volatile("s_waitcnt vmcnt(" #n ")" ::: "memory")
#define PG8_WAIT_L(n) asm volatile("s_waitcnt lgkmcnt(" #n ")" ::: "memory")
#define PG8_BAR __builtin_amdgcn_s_barrier()
#define PG8_SCHED __builtin_amdgcn_sched_barrier(0)
    Unit cur, nxt; int ui = 0;
    if (!S.next(0, cur)) return;
    f32x4 acc[2][2][4][2];
#pragma unroll
    for (int a = 0; a < 2; ++a)
#pragma unroll
        for (int b = 0; b < 2; ++b)
#pragma unroll
            for (int m = 0; m < 4; ++m)
#pragma unroll
                for (int n = 0; n < 2; ++n) acc[a][b][m][n] = (f32x4){0.f, 0.f, 0.f, 0.f};
    bf16x8 At[4][2], B0[2][2], B1[2][2];
    float rsv[8] = {1.f, 1.f, 1.f, 1.f, 1.f, 1.f, 1.f, 1.f};
    const char* cA = (const char*)g.A + (size_t)cur.pm * tstep; const char* cB = (const char*)g.Bt + (size_t)cur.pn * tstep;
    S.a_ready(cur);
    if constexpr (SP2) {
        PG8_STAGE(PG8_SB(0, 0), cB, voffB); PG8_STAGE(PG8_SB(0, 1), cB + hstep, voffB); PG8_STAGE(PG8_SA(0, 0), cA, voffA); PG8_STAGE(PG8_SA(0, 1), cA + hstep, voffA);
        if (wr == 1) PG8_BAR;
        PG8_WAIT_V(2); PG8_BAR;
        PG8_STAGE(PG8_SB(1, 0), cB + kstep, voffB); PG8_STAGE(PG8_SA(1, 0), cA + kstep, voffA); PG8_STAGE(PG8_SB(1, 1), cB + hstep + kstep, voffB);
        PG8_WAIT_V(6); PG8_BAR;
    } else {
        PG8_STAGE(PG8_SB(0, 0), cB, voffB); PG8_STAGE(PG8_SA(0, 0), cA, voffA); PG8_STAGE(PG8_SB(0, 1), cB + hstep, voffB); PG8_STAGE(PG8_SA(0, 1), cA + hstep, voffA);
        if (wr == 1) PG8_BAR;
        PG8_WAIT_V(4); PG8_BAR;
        PG8_STAGE(PG8_SB(1, 0), cB + kstep, voffB); PG8_STAGE(PG8_SA(1, 0), cA + kstep, voffA); PG8_STAGE(PG8_SB(1, 1), cB + hstep + kstep, voffB);
        PG8_WAIT_V(6); PG8_BAR;
    }
    for (;;) {
        const bool has_next = S.next(ui + 1, nxt);
        const char* nA = has_next ? (const char*)g.A + (size_t)nxt.pm * tstep : cA; const char* nB = has_next ? (const char*)g.Bt + (size_t)nxt.pn * tstep : cB;
        for (int t = 0; t < nt; t += 2) {
            const bool last = (t == nt - 2);
            if constexpr (Epi::HAS_RS) { if (last) {
                const int r0_ = cur.pm * BM + wr * 64 + fr;
                _Pragma("unroll") for (int ai_ = 0; ai_ < 2; ++ai_) _Pragma("unroll") for (int m_ = 0; m_ < 4; ++m_) rsv[4 * ai_ + m_] = E.rs[r0_ + ai_ * HALF + m_ * 16]; } }
            const char* a1 = cA + (size_t)(t + 1) * kstep;
            const char* a2 = last ? nA : cA + (size_t)(t + 2) * kstep; const char* b2 = last ? nB : cB + (size_t)(t + 2) * kstep;
            const char* a3 = a2 + kstep; const char* b3 = b2 + kstep;
            if (last && has_next) S.a_ready(nxt);
            if constexpr (SP2) {
            PG8_LDB(B0, 0, 0); PG8_LDB(B1, 0, 1); PG8_SCHED; PG8_LDA(At, 0, 0); PG8_STAGE(PG8_SA(1, 1), a1 + hstep, voffA);
            PG8_WAIT_V(8); PG8_WAIT_L(0); PG8_BAR; PG8_MMA(0, 0, At, B0); PG8_MMA(0, 1, At, B1); PG8_BAR; PG8_SCHED;
            PG8_LDA(At, 0, 1); PG8_STAGE(PG8_SB(0, 0), b2, voffB); PG8_STAGE(PG8_SB(0, 1), b2 + hstep, voffB); PG8_STAGE(PG8_SA(0, 0), a2, voffA);
            PG8_WAIT_V(8); PG8_WAIT_L(0); PG8_BAR; PG8_MMA(1, 0, At, B0); PG8_MMA(1, 1, At, B1); PG8_BAR; PG8_SCHED;
            PG8_LDB(B0, 1, 0); PG8_LDB(B1, 1, 1); PG8_SCHED; PG8_LDA(At, 1, 0); PG8_STAGE(PG8_SA(0, 1), a2 + hstep, voffA);
            PG8_WAIT_V(8); PG8_WAIT_L(0); PG8_BAR; PG8_MMA(0, 0, At, B0); PG8_MMA(0, 1, At, B1); PG8_BAR; PG8_SCHED;
            PG8_LDA(At, 1, 1); PG8_STAGE(PG8_SB(1, 0), b3, voffB); PG8_STAGE(PG8_SB(1, 1), b3 + hstep, voffB); PG8_STAGE(PG8_SA(1, 0), a3, voffA);
            PG8_WAIT_V(8); PG8_WAIT_L(0); PG8_BAR; PG8_MMA(1, 0, At, B0); PG8_MMA(1, 1, At, B1); PG8_BAR; PG8_SCHED;
            } else {
            PG8_LDB(B0, 0, 0); PG8_SCHED; PG8_LDA(At, 0, 0); PG8_STAGE(PG8_SA(1, 1), a1 + hstep, voffA);
            PG8_WAIT_L(8); PG8_BAR; PG8_WAIT_L(0); PG8_MMA(0, 0, At, B0); PG8_BAR; PG8_SCHED;
            PG8_LDB(B1, 0, 1); PG8_STAGE(PG8_SB(0, 0), b2, voffB);
            PG8_BAR; PG8_WAIT_L(0); PG8_MMA(0, 1, At, B1); PG8_BAR;
            PG8_LDA(At, 0, 1); PG8_STAGE(PG8_SA(0, 0), a2, voffA);
            PG8_BAR; PG8_WAIT_L(0); PG8_MMA(1, 0, At, B0); PG8_BAR; PG8_SCHED;
            PG8_STAGE(PG8_SB(0, 1), b2 + hstep, voffB);
            PG8_WAIT_V(6); PG8_BAR; PG8_MMA(1, 1, At, B1); PG8_BAR;
            PG8_LDB(B0, 1, 0); PG8_SCHED; PG8_LDA(At, 1, 0); PG8_STAGE(PG8_SA(0, 1), a2 + hstep, voffA);
            PG8_WAIT_L(8); PG8_BAR; PG8_WAIT_L(0); PG8_MMA(0, 0, At, B0); PG8_BAR; PG8_SCHED;
            PG8_LDB(B1, 1, 1); PG8_STAGE(PG8_SB(1, 0), b3, voffB);
            PG8_BAR; PG8_WAIT_L(0); PG8_MMA(0, 1, At, B1); PG8_BAR;
            PG8_LDA(At, 1, 1); PG8_STAGE(PG8_SA(1, 0), a3, voffA);
            PG8_BAR; PG8_WAIT_L(0); PG8_MMA(1, 0, At, B0); PG8_BAR; PG8_SCHED;
            PG8_STAGE(PG8_SB(1, 1), b3 + hstep, voffB);
            PG8_WAIT_V(6); PG8_BAR; PG8_MMA(1, 1, At, B1); PG8_BAR;
            }
        }
        if constexpr (ALIGN_EPI) { if (wr == 0) PG8_BAR; }
        if constexpr (!Epi::AFTER_DRAIN) { E(acc, cur, wr, wc, fr, fq, rsv); S.done(cur); }
        if (!has_next) break;
#pragma unroll
        for (int a = 0; a < 2; ++a)
#pragma unroll
            for (int b = 0; b < 2; ++b)
#pragma unroll
                for (int m = 0; m < 4; ++m)
#pragma unroll
                    for (int n = 0; n < 2; ++n) acc[a][b][m][n] = (f32x4){0.f, 0.f, 0.f, 0.f};
        cur = nxt; cA = nA; cB = nB; ++ui;
        if constexpr (ALIGN_EPI) { if (wr == 1) PG8_BAR; }
    }
    PG8_WAIT_V(0);
    if constexpr (!ALIGN_EPI) { if (wr == 0) PG8_BAR; }
    PG8_BAR;
    if constexpr (Epi::AFTER_DRAIN) { E.fused(acc, cur, wr, wc, fr, fq, lds, wid, lane); S.done(cur); }
#undef PG8_SA
#undef PG8_SB
#undef PG8_STAGE
#undef PG8_LDA
#undef PG8_LDB
#undef PG8_MMA
#undef PG8_WAIT_V
#undef PG8_WAIT_L
#undef PG8_BAR
#undef PG8_SCHED
}
}

#ifndef PG8_SP2
#define PG8_SP2 true
#endif
#ifndef PG8_ALIGN
#define PG8_ALIGN true
#endif
#include <hip/hip_bf16.h>
#include <cmath>
namespace attn_body {
using bf16=__hip_bfloat16;
using bf16x8=__attribute__((ext_vector_type(8)))short;
using s16x4=__attribute__((ext_vector_type(4)))short;
using f32x16=__attribute__((ext_vector_type(16)))float;
using u32x4=__attribute__((ext_vector_type(4)))unsigned;
constexpr int D=64;
constexpr int NW=8,QBLK=32,QB=QBLK*NW,KVBLK=64;
constexpr int ATTN_UNIT_ROWS=QB;
__device__ __forceinline__ int crow(int r,int hi){return (r&3)+8*(r>>2)+4*hi;}
#define SBAR() __builtin_amdgcn_sched_barrier(0)
__device__ __forceinline__ void wmask(f32x16&p0,f32x16&p1,int kb,int qpos){
  const float NEG=-INFINITY; const int d0=kb-qpos;
  #pragma unroll
  for(int r=0;r<16;++r){const int d=d0+(r&3)+8*(r>>2); if(d>128||d<-128)p0[r]=NEG; if(d+32>128||d+32<-128)p1[r]=NEG;}
}

constexpr int NSLOT=3, SLOTB=8192;
constexpr int VSLOTB=16384;
constexpr int LDS_K=0, LDS_V=NSLOT*SLOTB, LDS_WS=LDS_V+NSLOT*VSLOTB, LDS_OST=LDS_WS+NW*64*4, LDS_BYTES=LDS_OST+NW*4096;
constexpr float C2=0.125f*1.4426950408889634f;
__device__ __forceinline__ void glds16(const void*gsrc,unsigned lds_dst){unsigned keep;
  asm volatile("s_mov_b32 %0, m0\n\ts_mov_b32 m0, %2\n\ts_nop 0\n\tglobal_load_lds_dwordx4 %1, off\n\ts_mov_b32 m0, %0":"=&s"(keep):"v"(gsrc),"s"(lds_dst):"memory");}
__device__ __forceinline__ float max3f(float a,float b,float c){float r;asm("v_max3_f32 %0, %1, %2, %3":"=v"(r):"v"(a),"v"(b),"v"(c));return r;}
__device__ __forceinline__ float max2f(float a,float b){float r;asm("v_max_f32_e32 %0, %1, %2":"=v"(r):"v"(a),"v"(b));return r;}
__device__ __forceinline__ float fadd_s(float a,float b){float r;asm("v_add_f32_e32 %0, %1, %2":"=v"(r):"v"(a),"v"(b));return r;}
__device__ __forceinline__ float fsub_s(float a,float b){float r;asm("v_sub_f32_e32 %0, %1, %2":"=v"(r):"v"(a),"v"(b));return r;}
typedef float f32x2_t __attribute__((ext_vector_type(2))); typedef __bf16 bf16x2_t __attribute__((ext_vector_type(2)));
__device__ __forceinline__ unsigned cvtpk_s(float lo,float hi){f32x2_t v={lo,hi};bf16x2_t b=__builtin_convertvector(v,bf16x2_t);return __builtin_bit_cast(unsigned,b);}
#define WAIT_BAR(N) asm volatile("s_waitcnt vmcnt(" #N ") lgkmcnt(0)\n\ts_barrier":::"memory")

__device__ __forceinline__ void qkt(f32x16&p0,f32x16&p1,const char*Kslot,const bf16x8*qr,const f32x16&negm,int r32,int hi){
  const char*kb=Kslot+hi*1024+r32*16;
  #pragma unroll
  for(int d0=0;d0<4;++d0){
    const bf16x8 b0=*reinterpret_cast<const bf16x8*>(kb+d0*2048);
    const bf16x8 b1=*reinterpret_cast<const bf16x8*>(kb+d0*2048+512);
    if(d0==0){p0=__builtin_amdgcn_mfma_f32_32x32x16_bf16(b0,qr[0],negm,0,0,0);p1=__builtin_amdgcn_mfma_f32_32x32x16_bf16(b1,qr[0],negm,0,0,0);}
    else{p0=__builtin_amdgcn_mfma_f32_32x32x16_bf16(b0,qr[d0],p0,0,0,0);p1=__builtin_amdgcn_mfma_f32_32x32x16_bf16(b1,qr[d0],p1,0,0,0);}}
}
typedef __attribute__((address_space(3))) const char* lds_cptr;
typedef short v4i16_t __attribute__((ext_vector_type(4)));
__device__ __forceinline__ void kload8(bf16x8*kf,lds_cptr kp){
  kf[0]=*(const __attribute__((address_space(3))) bf16x8*)(kp);      kf[1]=*(const __attribute__((address_space(3))) bf16x8*)(kp+512);
  kf[2]=*(const __attribute__((address_space(3))) bf16x8*)(kp+2048); kf[3]=*(const __attribute__((address_space(3))) bf16x8*)(kp+2560);
  kf[4]=*(const __attribute__((address_space(3))) bf16x8*)(kp+4096); kf[5]=*(const __attribute__((address_space(3))) bf16x8*)(kp+4608);
  kf[6]=*(const __attribute__((address_space(3))) bf16x8*)(kp+6144); kf[7]=*(const __attribute__((address_space(3))) bf16x8*)(kp+6656);
}
__device__ __forceinline__ void kload2(bf16x8*kf,lds_cptr kp,int j){ kf[2*j]=*(const __attribute__((address_space(3))) bf16x8*)(kp+j*2048); kf[2*j+1]=*(const __attribute__((address_space(3))) bf16x8*)(kp+j*2048+512); }
__device__ __forceinline__ s16x4 vtr(lds_cptr p){ return __builtin_bit_cast(s16x4,__builtin_amdgcn_ds_read_tr16_b64_v4i16((__attribute__((address_space(3))) v4i16_t*)p)); }
__device__ __forceinline__ float rowmax(const f32x16&p0,const f32x16&p1){
  float a=max3f(p0[0],p0[1],p1[0]),b=max3f(p0[2],p0[3],p1[1]);a=max3f(a,p1[2],p1[3]);
  #pragma unroll
  for(int r=4;r<16;r+=4){a=max3f(a,p0[r],p0[r+1]);b=max3f(b,p0[r+2],p0[r+3]);a=max3f(a,p1[r],p1[r+1]);b=max3f(b,p1[r+2],p1[r+3]);}
  const float m=max2f(a,b);
  auto rr=__builtin_amdgcn_permlane32_swap(__float_as_uint(m),__float_as_uint(m),false,false);
  return max2f(__uint_as_float(rr[0]),__uint_as_float(rr[1]));
}
template<int ND> __device__ __forceinline__ void pv(f32x16*o,int vb,bf16x8 pa0,bf16x8 pa1,bf16x8 pa2,bf16x8 pa3){
  #pragma unroll
  for(int d0=0;d0<ND;++d0){s16x4 lo[4],hi[4];
    #pragma unroll
    for(int ks=0;ks<4;++ks){
      asm volatile("ds_read_b64_tr_b16 %0,%1 offset:%c2":"=&v"(lo[ks]):"v"(vb),"i"(d0*4096+ks*1024):"memory");
      asm volatile("ds_read_b64_tr_b16 %0,%1 offset:%c2":"=&v"(hi[ks]):"v"(vb),"i"(d0*4096+ks*1024+512):"memory");}
    asm volatile("s_waitcnt lgkmcnt(0)":::"memory");SBAR();
    #define PK(k) (bf16x8){lo[k][0],lo[k][1],lo[k][2],lo[k][3],hi[k][0],hi[k][1],hi[k][2],hi[k][3]}
    o[d0]=__builtin_amdgcn_mfma_f32_32x32x16_bf16(pa0,PK(0),o[d0],0,0,0);
    o[d0]=__builtin_amdgcn_mfma_f32_32x32x16_bf16(pa1,PK(1),o[d0],0,0,0);
    o[d0]=__builtin_amdgcn_mfma_f32_32x32x16_bf16(pa2,PK(2),o[d0],0,0,0);
    o[d0]=__builtin_amdgcn_mfma_f32_32x32x16_bf16(pa3,PK(3),o[d0],0,0,0);
    #undef PK
  }
}

#ifndef ATTN_STORE16
#define ATTN_STORE16(p,v) (*(u32x4*)(p)=(v))
#endif
template<int THRL,bool WIN,int DM,int ODM,int DV,int QMODE> __device__ __forceinline__ void attn_unit(const bf16*Qp,const bf16*__restrict__ Kp,const bf16*__restrict__ Vp,bf16*Op,const int q0,const int t_lo,const int NT,const float sink2,char*shm,const float*qgain,const float*qtab,const int b0,const bool pre,const bf16*nKp,const bf16*nVp){
  int tid_=threadIdx.x; asm volatile("":"+v"(tid_));
  const int tid=tid_,lane=tid&63,r32=lane&31,hi=lane>>5; const int wid=__builtin_amdgcn_readfirstlane(tid>>6);
  const bf16*Qw=WIN?Qp+(long)((wid&1)*QBLK)*DM+(wid>>1)*64:Qp+(long)(wid*QBLK)*DM;
  const bf16*Kh=Kp+(long)t_lo*KVBLK*DM,*Vh=Vp+(long)t_lo*KVBLK*DM;
  const unsigned lds0=(unsigned)(uintptr_t)shm;
  float*wsf=(float*)(shm+LDS_WS)+wid*64;
  const bf16*ksrc=Kh+(long)lane*DM+wid*8;
  const bf16*vsrc=Vh+(long)(16*(wid&3)+(lane>>2))*DM+(wid>>2)*32+(lane&3)*8;
  const unsigned kdst=lds0+LDS_K+wid*1024, vdst=lds0+LDS_V+wid*1024;
  #define DMA_K(t,slot) glds16(ksrc+(long)(t)*KVBLK*DM,(unsigned)__builtin_amdgcn_readfirstlane(kdst+(slot)))
  constexpr int VM=DV/64;
  #define DMA_V(t,slot) do{ glds16(vsrc+(long)(t)*KVBLK*DM,(unsigned)__builtin_amdgcn_readfirstlane(vdst+VM*(slot))); \
    if constexpr(DV==128){ glds16(vsrc+64+(long)(t)*KVBLK*DM,(unsigned)__builtin_amdgcn_readfirstlane(vdst+VM*(slot)+8192)); } }while(0)
  #define WAIT_KV() do{ if constexpr(DV==128){WAIT_BAR(3);} else {WAIT_BAR(2);} }while(0)
  #define WAIT_V1() do{ if constexpr(DV==128){WAIT_BAR(2);} else {WAIT_BAR(1);} }while(0)
  const int vb0=(int)(lds0+LDS_V)+((lane>>4)&1)*32+(lane&3)*8+(4*hi+((lane&15)>>2))*64;
  const char*Kbase=shm+LDS_K; bf16x8 kf[8];
  const lds_cptr shm3=(lds_cptr)shm; const lds_cptr kp0=shm3+LDS_K+hi*1024+r32*16; const lds_cptr vp0=shm3+LDS_V+((lane>>4)&1)*32+(lane&3)*8+(4*hi+((lane&15)>>2))*64;
  const int s0=b0*SLOTB,s1=(s0==(NSLOT-1)*SLOTB)?0:s0+SLOTB,s2=(s1==(NSLOT-1)*SLOTB)?0:s1+SLOTB;
  if(!pre){DMA_K(0,s0);DMA_V(0,s0);DMA_K(1,s1);}
  bf16x8 qr[4];
  #pragma unroll
  for(int d0=0;d0<4;++d0)qr[d0]=__builtin_nontemporal_load(reinterpret_cast<const bf16x8*>(&Qw[(long)r32*DM+d0*16+hi*8]));
  float mhat=0.f,l_reg=0.f;f32x16 o[DV/32];
  #pragma unroll
  for(int d_=0;d_<DV/32;++d_)o[d_]=f32x16{};
  f32x16 negm=f32x16{};asm volatile("":"+v"(negm));
  const int qpos=WIN?q0+(wid&1)*QBLK+r32:q0+wid*QBLK+r32;
  #define CMASK(P0,P1,t) do{ if constexpr(WIN){ wmask(P0,P1,(t_lo+(t))*KVBLK+4*hi,qpos); } }while(0)
  bool resc=false;
  #define START(P0,P1) do{ const float rm=rowmax(P0,P1); resc=false; \
    { const float dl=WIN?__builtin_fmaxf(rm,-64.f):rm; mhat=fadd_s(mhat,dl); \
      _Pragma("unroll") for(int r=0;r<16;++r){P0[r]=fsub_s(P0[r],dl);P1[r]=fsub_s(P1[r],dl);} \
      _Pragma("unroll") for(int r=0;r<16;++r)negm[r]=-mhat; asm volatile("":"+v"(negm)); } \
    _Pragma("unroll") for(int r=0;r<16;++r)P0[r]=__builtin_amdgcn_exp2f(P0[r]); }while(0)
  #define RESC() do{ if(resc){ asm volatile("s_waitcnt lgkmcnt(0)":::"memory"); \
      _Pragma("unroll") for(int d_=0;d_<DV/32;++d_) _Pragma("unroll") for(int r=0;r<16;++r)o[d_][r]*=wsf[crow(r,hi)]; } }while(0)
  f32x16 pA0,pA1,pB0,pB1;
  int sl_prev=s0,sl_cur=s0,sl_next=s1;
  #define ROT() do{sl_prev=sl_cur;sl_cur=sl_next;sl_next=(sl_next==(NSLOT-1)*SLOTB)?0:sl_next+SLOTB;}while(0)
  if(!pre){DMA_K(2,s2);}
  if constexpr(QMODE!=0){
    typedef float f32x4_t __attribute__((ext_vector_type(4)));
    constexpr float QS=0.125f*1.4426950408889634f;
    float v[4][8];
    #pragma unroll
    for(int d0=0;d0<4;++d0){
      #pragma unroll
      for(int e=0;e<8;++e)v[d0][e]=__builtin_bit_cast(float,((unsigned)(unsigned short)qr[d0][e])<<16);}
    const int bp=(lane^32)<<2;
    if constexpr(QMODE==1){
      float ss=0.f;
      #pragma unroll
      for(int d0=0;d0<4;++d0){
        #pragma unroll
        for(int e=0;e<8;++e)ss+=v[d0][e]*v[d0][e];}
      ss+=__builtin_bit_cast(float,__builtin_amdgcn_ds_bpermute(bp,__builtin_bit_cast(int,ss)));
      const float rn=__builtin_amdgcn_rsqf(ss*(1.f/64.f)+1e-6f);
      const int trow=qpos>>6,tcol=qpos&63;
      #pragma unroll
      for(int d0=0;d0<4;++d0){ const f32x4_t g0=*(const f32x4_t*)(qgain+16*d0+8*hi),g1=*(const f32x4_t*)(qgain+16*d0+8*hi+4);
        const float g[8]={g0.x,g0.y,g0.z,g0.w,g1.x,g1.y,g1.z,g1.w};
        #pragma unroll
        for(int e=0;e<8;++e)v[d0][e]=(v[d0][e]*rn)*g[e];}
      #pragma unroll
      for(int h2=0;h2<2;++h2){ const float*tb=qtab+((h2==0?trow:tcol)*16+8*hi)*2;
        const f32x4_t c0=*(const f32x4_t*)(tb),c1=*(const f32x4_t*)(tb+4),c2=*(const f32x4_t*)(tb+8),c3=*(const f32x4_t*)(tb+12);
        const float cc[8]={c0.x,c0.z,c1.x,c1.z,c2.x,c2.z,c3.x,c3.z},sn[8]={c0.y,c0.w,c1.y,c1.w,c2.y,c2.w,c3.y,c3.w};
        #pragma unroll
        for(int e=0;e<8;++e){ const float x1=v[2*h2][e],x2=v[2*h2+1][e]; v[2*h2][e]=x1*cc[e]-x2*sn[e]; v[2*h2+1][e]=x2*cc[e]+x1*sn[e]; } }
    } else {
      const float*tb=qtab+(size_t)qpos*16;
      const f32x4_t c0=*(const f32x4_t*)(tb),c1=*(const f32x4_t*)(tb+4),c2=*(const f32x4_t*)(tb+8),c3=*(const f32x4_t*)(tb+12);
      const float cc[8]={c0.x,c0.z,c1.x,c1.z,c2.x,c2.z,c3.x,c3.z},sn[8]={c0.y,c0.w,c1.y,c1.w,c2.y,c2.w,c3.y,c3.w};
      const float sg=hi?1.f:-1.f;
      #pragma unroll
      for(int e=0;e<8;++e){ const float p=__builtin_bit_cast(float,__builtin_amdgcn_ds_bpermute(bp,__builtin_bit_cast(int,v[0][e]))); v[0][e]=v[0][e]*cc[e]+sg*(p*sn[e]); }
    }
    #pragma unroll
    for(int d0=0;d0<4;++d0){ u32x4 w; w[0]=cvtpk_s(v[d0][0]*QS,v[d0][1]*QS); w[1]=cvtpk_s(v[d0][2]*QS,v[d0][3]*QS); w[2]=cvtpk_s(v[d0][4]*QS,v[d0][5]*QS); w[3]=cvtpk_s(v[d0][6]*QS,v[d0][7]*QS);
      qr[d0]=__builtin_bit_cast(bf16x8,w); }
  }
  WAIT_BAR(3);
  qkt(pA0,pA1,Kbase+s0,qr,negm,r32,hi);asm volatile("s_nop 15\n\ts_nop 7":"+v"(pA0),"+v"(pA1));CMASK(pA0,pA1,0);
  START(pA0,pA1);
  _Pragma("unroll") for(int r=0;r<16;++r)pA1[r]=__builtin_amdgcn_exp2f(pA1[r]);
  WAIT_BAR(0);
  DMA_K(3,s0);DMA_V(1,s1);
  ROT();
  kload8(kf,kp0+sl_cur);
  WAIT_KV();
  s16x4 vlo[8],vhi[8]; u32x4 pw0,pw1,pw2,pw3;
  #define PKW(P,B) cvtpk_s(P[B],P[B+1])
  #define PAF(k) __builtin_bit_cast(bf16x8,pw##k)
  #define VFR(i) (bf16x8){vlo[i][0],vlo[i][1],vlo[i][2],vlo[i][3],vhi[i][0],vhi[i][1],vhi[i][2],vhi[i][3]}
  #define PIN(x) asm volatile("":"+v"(x))
  #define MX3(a,b,c) __builtin_fmaxf(__builtin_fmaxf((a),(b)),(c))
  #define GAPA(MF,A0,A1,A2,A3,W0,W1,PW) do{ MF; sacc+=A0; sacc+=A1; sacc+=A2; sacc+=A3; PIN(sacc); W0; W1; PIN(PW); SBAR(); }while(0)
  #define EX(v) __builtin_amdgcn_exp2f(v)
  #define GAPB(MF,X,B) do{ MF; X[B]=EX(X[B]); X[B+1]=EX(X[B+1]); X[B+2]=EX(X[B+2]); X[B+3]=EX(X[B+3]); PIN(X); SBAR(); }while(0)
  #define VRD(i) do{ vlo[i]=vtr(vp_+(((i)>>2)*4096+((i)&3)*1024)); vhi[i]=vtr(vp_+(((i)>>2)*4096+((i)&3)*1024+512)); }while(0)
  #define KRD(G,j) do{ if(G){ kload2(kf,kp0+sl_next,j); SBAR(); } }while(0)
  #define VRD2(i) do{ if constexpr(DV==128){ vlo[i]=vtr(vp_+((((i)>>2)+2)*4096+((i)&3)*1024)); vhi[i]=vtr(vp_+((((i)>>2)+2)*4096+((i)&3)*1024+512)); SBAR(); } }while(0)
  #define GAPC(MF) do{ MF; SBAR(); }while(0)
  #define GAPB2(MF,X,B) do{ MF; X[B]=EX(X[B]); X[B+1]=EX(X[B+1]); PIN(X); SBAR(); }while(0)
  #define STEP(C0,C1,P0,P1,t,GK,GV,GL) do{ SBAR(); \
    const lds_cptr vp_=vp0+VM*sl_prev; \
    VRD(0); SBAR(); float sacc=(P0[0]+P0[1]); \
    GAPA(C0=__builtin_amdgcn_mfma_f32_32x32x16_bf16(kf[0],qr[0],negm,0,0,0), P0[2],P0[3],P0[4],P0[5],     pw0[0]=PKW(P0,0), pw0[1]=PKW(P0,2), pw0); \
    VRD(4); SBAR(); GAPA(C1=__builtin_amdgcn_mfma_f32_32x32x16_bf16(kf[1],qr[0],negm,0,0,0), P0[6],P0[7],P0[8],P0[9],     pw0[2]=PKW(P0,4), pw0[3]=PKW(P0,6), pw0); \
    VRD(1); SBAR(); GAPA(C0=__builtin_amdgcn_mfma_f32_32x32x16_bf16(kf[2],qr[1],C0,0,0,0),   P0[10],P0[11],P0[12],P0[13], pw1[0]=PKW(P0,8), pw1[1]=PKW(P0,10), pw1); \
    VRD(5); SBAR(); GAPA(C1=__builtin_amdgcn_mfma_f32_32x32x16_bf16(kf[3],qr[1],C1,0,0,0),   P0[14],P0[15],P1[0],P1[1],   pw1[2]=PKW(P0,12),pw1[3]=PKW(P0,14), pw1); \
    VRD(2); SBAR(); GAPA(C0=__builtin_amdgcn_mfma_f32_32x32x16_bf16(kf[4],qr[2],C0,0,0,0),   P1[2],P1[3],P1[4],P1[5],     pw2[0]=PKW(P1,0), pw2[1]=PKW(P1,2), pw2); \
    VRD(6); SBAR(); GAPA(C1=__builtin_amdgcn_mfma_f32_32x32x16_bf16(kf[5],qr[2],C1,0,0,0),   P1[6],P1[7],P1[8],P1[9],     pw2[2]=PKW(P1,4), pw2[3]=PKW(P1,6), pw2); \
    VRD(3); SBAR(); GAPA(C0=__builtin_amdgcn_mfma_f32_32x32x16_bf16(kf[6],qr[3],C0,0,0,0),   P1[10],P1[11],P1[12],P1[13], pw3[0]=PKW(P1,8), pw3[1]=PKW(P1,10), pw3); \
    VRD(7); SBAR(); GAPA(C1=__builtin_amdgcn_mfma_f32_32x32x16_bf16(kf[7],qr[3],C1,0,0,0),   P1[14],P1[15],0.f,0.f,       pw3[2]=PKW(P1,12),pw3[3]=PKW(P1,14), pw3); \
    l_reg+=sacc; \
    if(GK){DMA_K((t)+3,sl_cur);} if(GV){DMA_V((t)+1,sl_next);} \
    CMASK(C0,C1,t); \
    { float a=MX3(C0[0],C0[1],C1[0]),b=MX3(C0[2],C0[3],C1[1]); a=MX3(a,C1[2],C1[3]); \
      _Pragma("unroll") for(int r=4;r<16;r+=4){a=MX3(a,C0[r],C0[r+1]);b=MX3(b,C0[r+2],C0[r+3]);a=MX3(a,C1[r],C1[r+1]);b=MX3(b,C1[r+2],C1[r+3]);} \
      float rm=__builtin_fmaxf(a,b); { auto rr=__builtin_amdgcn_permlane32_swap(__float_as_uint(rm),__float_as_uint(rm),false,false); rm=__builtin_fmaxf(__uint_as_float(rr[0]),__uint_as_float(rr[1])); } \
      resc=false; \
      if(__builtin_expect(__any(rm>(float)THRL),0)){ const float dl=__builtin_fmaxf(rm,0.f); mhat+=dl; \
        _Pragma("unroll") for(int r=0;r<16;++r){C0[r]-=dl;C1[r]-=dl;} \
        _Pragma("unroll") for(int r=0;r<16;++r)negm[r]=-mhat; asm volatile("":"+v"(negm)); \
        const float f=__builtin_amdgcn_exp2f(-dl); l_reg*=f; if(hi==0)wsf[r32]=f; resc=true; } } \
    SBAR(); \
    if constexpr(DV==64){ \
    GAPB(o[0]=__builtin_amdgcn_mfma_f32_32x32x16_bf16(PAF(0),VFR(0),o[0],0,0,0), C0,0); \
    GAPB(o[1]=__builtin_amdgcn_mfma_f32_32x32x16_bf16(PAF(0),VFR(4),o[1],0,0,0), C0,4); \
    KRD(GL,0); GAPB(o[0]=__builtin_amdgcn_mfma_f32_32x32x16_bf16(PAF(1),VFR(1),o[0],0,0,0), C0,8); \
    KRD(GL,1); GAPB(o[1]=__builtin_amdgcn_mfma_f32_32x32x16_bf16(PAF(1),VFR(5),o[1],0,0,0), C0,12); \
    KRD(GL,2); GAPB(o[0]=__builtin_amdgcn_mfma_f32_32x32x16_bf16(PAF(2),VFR(2),o[0],0,0,0), C1,0); \
    KRD(GL,3); GAPB(o[1]=__builtin_amdgcn_mfma_f32_32x32x16_bf16(PAF(2),VFR(6),o[1],0,0,0), C1,4); \
    GAPB(o[0]=__builtin_amdgcn_mfma_f32_32x32x16_bf16(PAF(3),VFR(3),o[0],0,0,0), C1,8); \
    GAPB(o[1]=__builtin_amdgcn_mfma_f32_32x32x16_bf16(PAF(3),VFR(7),o[1],0,0,0), C1,12); \
    } else {   \
    GAPB2(o[0]=__builtin_amdgcn_mfma_f32_32x32x16_bf16(PAF(0),VFR(0),o[0],0,0,0), C0,0);  VRD2(0); \
    GAPB2(o[1]=__builtin_amdgcn_mfma_f32_32x32x16_bf16(PAF(0),VFR(4),o[1],0,0,0), C0,2);  VRD2(4); \
    GAPB2(o[0]=__builtin_amdgcn_mfma_f32_32x32x16_bf16(PAF(1),VFR(1),o[0],0,0,0), C0,4);  VRD2(1); \
    GAPB2(o[1]=__builtin_amdgcn_mfma_f32_32x32x16_bf16(PAF(1),VFR(5),o[1],0,0,0), C0,6);  VRD2(5); \
    GAPB2(o[0]=__builtin_amdgcn_mfma_f32_32x32x16_bf16(PAF(2),VFR(2),o[0],0,0,0), C0,8);  VRD2(2); \
    GAPB2(o[1]=__builtin_amdgcn_mfma_f32_32x32x16_bf16(PAF(2),VFR(6),o[1],0,0,0), C0,10); VRD2(6); \
    GAPB2(o[0]=__builtin_amdgcn_mfma_f32_32x32x16_bf16(PAF(3),VFR(3),o[0],0,0,0), C0,12); VRD2(3); \
    GAPB2(o[1]=__builtin_amdgcn_mfma_f32_32x32x16_bf16(PAF(3),VFR(7),o[1],0,0,0), C0,14); VRD2(7); \
    GAPB2(o[DV/32-2]=__builtin_amdgcn_mfma_f32_32x32x16_bf16(PAF(0),VFR(0),o[DV/32-2],0,0,0), C1,0); \
    GAPB2(o[DV/32-1]=__builtin_amdgcn_mfma_f32_32x32x16_bf16(PAF(0),VFR(4),o[DV/32-1],0,0,0), C1,2); \
    KRD(GL,0); GAPB2(o[DV/32-2]=__builtin_amdgcn_mfma_f32_32x32x16_bf16(PAF(1),VFR(1),o[DV/32-2],0,0,0), C1,4); \
    KRD(GL,1); GAPB2(o[DV/32-1]=__builtin_amdgcn_mfma_f32_32x32x16_bf16(PAF(1),VFR(5),o[DV/32-1],0,0,0), C1,6); \
    KRD(GL,2); GAPB2(o[DV/32-2]=__builtin_amdgcn_mfma_f32_32x32x16_bf16(PAF(2),VFR(2),o[DV/32-2],0,0,0), C1,8); \
    KRD(GL,3); GAPB2(o[DV/32-1]=__builtin_amdgcn_mfma_f32_32x32x16_bf16(PAF(2),VFR(6),o[DV/32-1],0,0,0), C1,10); \
    GAPB2(o[DV/32-2]=__builtin_amdgcn_mfma_f32_32x32x16_bf16(PAF(3),VFR(3),o[DV/32-2],0,0,0), C1,12); \
    GAPB2(o[DV/32-1]=__builtin_amdgcn_mfma_f32_32x32x16_bf16(PAF(3),VFR(7),o[DV/32-1],0,0,0), C1,14); \
    } \
    }while(0)
  int t=1;
  for(;t+5<NT;t+=2){
    STEP(pB0,pB1,pA0,pA1,t,true,true,true);     WAIT_KV(); RESC(); ROT();
    STEP(pA0,pA1,pB0,pB1,t+1,true,true,true);   WAIT_KV(); RESC(); ROT();
  }
  #define ENDW(tt) do{ if((tt)+3<NT){WAIT_KV();} else if((tt)+2<NT){WAIT_V1();} else {WAIT_BAR(0);} }while(0)
  for(;t+1<NT;t+=2){
    STEP(pB0,pB1,pA0,pA1,t,(t+3<NT),(t+1<NT),(t+1<NT));       ENDW(t);   RESC(); ROT();
    STEP(pA0,pA1,pB0,pB1,t+1,(t+4<NT),(t+2<NT),(t+2<NT));     ENDW(t+1); RESC(); ROT();
  }
  STEP(pB0,pB1,pA0,pA1,NT-1,false,false,false); RESC();
  { float sacc=pB0[0]+pB0[1]; _Pragma("unroll") for(int r=2;r<16;++r)sacc+=pB0[r]; _Pragma("unroll") for(int r=0;r<16;++r)sacc+=pB1[r]; l_reg+=sacc;
    pw0=(u32x4){PKW(pB0,0),PKW(pB0,2),PKW(pB0,4),PKW(pB0,6)};pw1=(u32x4){PKW(pB0,8),PKW(pB0,10),PKW(pB0,12),PKW(pB0,14)};pw2=(u32x4){PKW(pB1,0),PKW(pB1,2),PKW(pB1,4),PKW(pB1,6)};pw3=(u32x4){PKW(pB1,8),PKW(pB1,10),PKW(pB1,12),PKW(pB1,14)};
    SBAR(); pv<DV/32>(o,vb0+VM*sl_cur,PAF(0),PAF(1),PAF(2),PAF(3)); }
  if(nKp){
    const int n0=(sl_cur==(NSLOT-1)*SLOTB)?0:sl_cur+SLOTB,n1=(n0==(NSLOT-1)*SLOTB)?0:n0+SLOTB,n2=(n1==(NSLOT-1)*SLOTB)?0:n1+SLOTB;
    const bf16*nks=nKp+(long)lane*DM+wid*8; const bf16*nvs=nVp+(long)(16*(wid&3)+(lane>>2))*DM+(wid>>2)*32+(lane&3)*8;
    glds16(nks,(unsigned)__builtin_amdgcn_readfirstlane(kdst+n0));
    glds16(nvs,(unsigned)__builtin_amdgcn_readfirstlane(vdst+VM*n0)); if constexpr(DV==128){ glds16(nvs+64,(unsigned)__builtin_amdgcn_readfirstlane(vdst+VM*n0+8192)); }
    glds16(nks+(long)KVBLK*DM,(unsigned)__builtin_amdgcn_readfirstlane(kdst+n1));
    glds16(nks+(long)2*KVBLK*DM,(unsigned)__builtin_amdgcn_readfirstlane(kdst+n2)); }
  #undef PKW
  #undef PAF
  #undef VFR
  #undef PIN
  #undef MX3
  #undef GAPA
  #undef GAPB
  #undef EX
  #undef VRD
  #undef KRD
  #undef STEP
  #undef ENDW
  {auto rr=__builtin_amdgcn_permlane32_swap(__float_as_uint(l_reg),__float_as_uint(l_reg),false,false);l_reg=__uint_as_float(rr[0])+__uint_as_float(rr[1]);}
  if constexpr(WIN){ l_reg+=__builtin_amdgcn_exp2f(qgain[wid>>1]*1.4426950408889634f-mhat); }
  if(hi==0)wsf[32+r32]=l_reg;asm volatile("s_waitcnt lgkmcnt(0)":::"memory");
  float rli[16];
  #pragma unroll
  for(int r=0;r<16;++r)rli[r]=__builtin_amdgcn_rcpf(wsf[32+crow(r,hi)]);
  bf16*Ow=WIN?Op+(long)((wid&1)*QBLK)*ODM+(wid>>1)*64:Op+(long)(wid*QBLK)*ODM;
  #pragma unroll
  for(int hf=0;hf<DV/64;++hf){ bf16*stg=(bf16*)(shm+LDS_OST)+wid*2048;
    #pragma unroll
    for(int r=0;r<16;++r){const int orow=crow(r,hi);
      #pragma unroll
      for(int d0=0;d0<2;++d0)stg[orow*64+d0*32+r32]=__float2bfloat16(o[2*hf+d0][r]*rli[r]);}
    asm volatile("s_waitcnt lgkmcnt(0)":::"memory");
    #pragma unroll
    for(int i=0;i<4;++i){const int row=i*8+(lane>>3),ch=lane&7; const u32x4 v=*(const u32x4*)(stg+row*64+ch*8); ATTN_STORE16(Ow+(long)row*ODM+hf*64+ch*8,v);}
    asm volatile("s_waitcnt lgkmcnt(0)":::"memory"); }
  asm volatile("s_waitcnt lgkmcnt(0)\n\ts_barrier":::"memory");
  #undef DMA_K
  #undef DMA_V
  #undef WAIT_KV
  #undef WAIT_V1
  #undef VRD2
  #undef GAPC
  #undef GAPB2
  #undef CMASK
  #undef START
  #undef RESC
  #undef ROT
}
constexpr int ATTN_LDS_BYTES=LDS_BYTES;
#undef SBAR
#undef WAIT_BAR
}
#include <hip/hip_cooperative_groups.h>
namespace cg = cooperative_groups;
constexpr int NWAVES = 8;
constexpr int DMODEL = 1024, MP = 65536, MS_ = 16384, MTOK = MP + MS_;
constexpr int EVEN_IN = 2304, ODD_IN = 1536, FFH = 2816, GU = 2 * FFH;
constexpr float EPSN = 1e-6f;
constexpr float QSCALE = 0.125f * 1.4426950408889634f;
constexpr size_t MiB = 1u << 20;
constexpr size_t WS_ROPE = 0, WS_AX = 512 * 1024, WS_BAR = 576 * 1024, WS_RS = 640 * 1024;
constexpr size_t WS_WINE = 1 * MiB, WS_WOUTE = 10 * MiB, WS_WINO = 14 * MiB, WS_WOUTO = 20 * MiB, WS_WGU = 24 * MiB, WS_WDN = 68 * MiB;
constexpr size_t WS_H = 90 * MiB;
constexpr size_t WS_OB = 250 * MiB;
constexpr size_t WS_QKV = 410 * MiB;
constexpr size_t WS_ATT = 90 * MiB;
constexpr size_t WS_XB = 850 * MiB;
constexpr size_t WS_HID = 410 * MiB;
constexpr size_t WS_END = 1010 * MiB;
constexpr int LDS_BYTES = 147456;

#define GAS __attribute__((address_space(1)))
#define LAS __attribute__((address_space(3)))
typedef unsigned short bf16;
typedef unsigned v4u __attribute__((ext_vector_type(4)));
typedef unsigned v2u __attribute__((ext_vector_type(2)));
typedef float f32x4 __attribute__((ext_vector_type(4)));
typedef float f32x2 __attribute__((ext_vector_type(2)));
#define LDS_WAIT() asm volatile("s_waitcnt lgkmcnt(0)" ::: "memory")
__device__ __forceinline__ unsigned f2bf(float f) { unsigned u = __builtin_bit_cast(unsigned, f); return (u + 0x7fffu + ((u >> 16) & 1u)) >> 16; }
__device__ __forceinline__ unsigned pk2(float lo, float hi) { return f2bf(lo) | (f2bf(hi) << 16); }
__device__ __forceinline__ float bflo(unsigned w) { return __builtin_bit_cast(float, w << 16); }
__device__ __forceinline__ float bfhi(unsigned w) { return __builtin_bit_cast(float, w & 0xffff0000u); }
template <int CTRL> __device__ __forceinline__ float dppf(float v) { return __builtin_bit_cast(float, __builtin_amdgcn_update_dpp(0, __builtin_bit_cast(int, v), CTRL, 0xf, 0xf, false)); }
#define DPP_XOR1 0xB1
#define DPP_XOR2 0x4E
#define DPP_HMIR 0x141
#define DPP_MIR  0x140
__device__ __forceinline__ float sum8(float v) { v += dppf<DPP_XOR1>(v); v += dppf<DPP_XOR2>(v); v += dppf<DPP_HMIR>(v); return v; }
__device__ __forceinline__ float sum16(float v) { v = sum8(v); v += dppf<DPP_MIR>(v); return v; }
__device__ __forceinline__ float bperm_xor(float v, int lane, int m) { return __builtin_bit_cast(float, __builtin_amdgcn_ds_bpermute((lane ^ m) << 2, __builtin_bit_cast(int, v))); }
__device__ __forceinline__ float wave_sum(float v, int lane) { v = sum16(v); v += bperm_xor(v, lane, 16); v += bperm_xor(v, lane, 32); return v; }
__constant__ float ROPE_INV[8] = {1.f, 0.193922743f, 0.0376060307f, 0.00729266461f, 0.00141421356f, 0.000274248188f, 5.31829573e-05f, 1.03133852e-05f};
__constant__ float AX_INV[16] = {1.f, 0.562341332f, 0.316227764f, 0.177827939f, 0.100000001f, 0.0562341325f, 0.0316227749f, 0.0177827943f, 0.00999999978f, 0.00562341325f,
                                 0.00316227763f, 0.00177827943f, 0.00100000005f, 0.000562341302f, 0.000316227757f, 0.00017782794f};


__device__ __forceinline__ void transpose_item(const float* W, int K, int N, bf16* WT, int swiglu, LAS float* scr, int item, int lane, const float* kgain) {
    const int nblk = N / 32, kb = item / nblk, nb = item % nblk, k0 = 64 * kb, n0 = 32 * nb;
    int drow0 = n0;
    if (swiglu) { const int s = n0 / FFH, j0 = n0 % FFH; drow0 = 256 * (j0 / 128) + 128 * s + (j0 % 128); }
#pragma unroll 8
    for (int i = 0; i < 32; ++i) { const int kk = 2 * i + (lane >> 5); scr[kk * 33 + (lane & 31)] = __builtin_nontemporal_load(W + (size_t)(k0 + kk) * N + n0 + (lane & 31)) * (kgain ? kgain[k0 + kk] : 1.f); }
    LDS_WAIT(); asm volatile("" ::: "memory");
    const int c = lane & 7;
#pragma unroll
    for (int j = 0; j < 4; ++j) { const int n = (lane >> 3) + 8 * j; const LAS float* s = scr + (8 * c) * 33 + n;
        v4u o; o.x = pk2(s[0 * 33], s[1 * 33]); o.y = pk2(s[2 * 33], s[3 * 33]); o.z = pk2(s[4 * 33], s[5 * 33]); o.w = pk2(s[6 * 33], s[7 * 33]);
        *(GAS v4u*)(WT + (size_t)(drow0 + n) * K + k0 + 8 * c) = o; }
    LDS_WAIT(); asm volatile("" ::: "memory");
}

__device__ __forceinline__ f32x2 cossin(float ang) {
    const double a = (double)ang; const double k = __builtin_rint(a * 0.63661977236758134308); const double r = a - k * 1.57079632679489661923;
    const double r2 = r * r;
    const double sn = r * (1.0 + r2 * (-1.0 / 6 + r2 * (1.0 / 120 + r2 * (-1.0 / 5040 + r2 * (1.0 / 362880 + r2 * (-1.0 / 39916800 + r2 * (1.0 / 6227020800.0)))))));
    const double cs = 1.0 + r2 * (-0.5 + r2 * (1.0 / 24 + r2 * (-1.0 / 720 + r2 * (1.0 / 40320 + r2 * (-1.0 / 3628800 + r2 * (1.0 / 479001600.0))))));
    const int q = ((int)k) & 3;
    const double c = (q == 0) ? cs : (q == 1) ? -sn : (q == 2) ? -cs : sn;
    const double s = (q == 0) ? sn : (q == 1) ? cs : (q == 2) ? -sn : -cs;
    return (f32x2){(float)c, (float)s};
}

#define XB_TMO      128
#define XB_XCNT(j)  (256  + 64 * (j))
#define XB_XSUB(j)  (1280 + 64 * (j))
#define XB_XGEN(j)  (2304 + 64 * (j))
#define XB_TOP      3328
#define XB_TOPGEN   3392
#define XCD_BAR_WORDS 3456
#define XB_SPIN_CAP (1u << 18)

__device__ __forceinline__ unsigned xb_ld(unsigned* p)              { return __hip_atomic_load(p, __ATOMIC_RELAXED, __HIP_MEMORY_SCOPE_AGENT); }
__device__ __forceinline__ unsigned xb_add(unsigned* p, unsigned v) { return __hip_atomic_fetch_add(p, v, __ATOMIC_RELAXED, __HIP_MEMORY_SCOPE_AGENT); }
__device__ __forceinline__ unsigned xb_xcc_id() { return (unsigned)__builtin_amdgcn_s_getreg((3 << 11) | 20) & 0xFu; }
#define XB_SPIN(cond, bar) do { unsigned _sp = 0; while (cond) { __builtin_amdgcn_s_sleep(1); \
    if ((++_sp & 255u) == 0u) { if (xb_ld(&(bar)[XB_TMO])) break; if (_sp > XB_SPIN_CAP) { atomicAdd(&(bar)[XB_TMO], 1u); break; } } } } while (0)

struct XcdBarrier {
    unsigned* bar; unsigned x;
    volatile LAS unsigned* st;
};

__device__ __forceinline__ XcdBarrier xcd_barrier_post(unsigned* bar, volatile LAS unsigned* st) {
    XcdBarrier b; b.bar = bar; b.x = xb_xcc_id(); b.st = st;
    if (threadIdx.x == 0) (void)xb_add(&bar[XB_XCNT(b.x)], 1u);
    return b;
}
__device__ __forceinline__ void xcd_barrier_complete(unsigned* bar, unsigned x, unsigned& nloc, unsigned& nx) {
    const unsigned G = gridDim.x * gridDim.y * gridDim.z;
    unsigned sum, cnt, mine, sp = 0u;
    for (;;) {
        sum = 0u; cnt = 0u; mine = 0u;
#pragma unroll
        for (unsigned j = 0; j < 16; ++j) { const unsigned c = xb_ld(&bar[XB_XCNT(j)]); sum += c; cnt += (c > 0u) ? 1u : 0u; mine = (j == x) ? c : mine; }
        if (sum == G) break;
        __builtin_amdgcn_s_sleep(1);
        if ((++sp & 255u) == 0u) { if (xb_ld(&bar[XB_TMO])) break; if (sp > XB_SPIN_CAP) { atomicAdd(&bar[XB_TMO], 1u); break; } }
    }
    nloc = mine > 0u ? mine : 1u; nx = cnt > 0u ? cnt : 1u;
}

__device__ __forceinline__ void xcd_barrier(const XcdBarrier& b) {
    asm volatile("s_waitcnt vmcnt(0)" ::: "memory");
    __syncthreads();
    if (threadIdx.x == 0) {
        unsigned* bar = b.bar;
        __builtin_amdgcn_s_waitcnt(0);
        unsigned nloc = b.st[0], nx = b.st[1];
        if (nloc == 0u) { xcd_barrier_complete(bar, b.x, nloc, nx); b.st[0] = nloc; b.st[1] = nx; }
        const unsigned old = xb_add(&bar[XB_XSUB(b.x)], 1u);
        const unsigned gen = old / nloc;
        if (old + 1u == (gen + 1u) * nloc) {
            __builtin_amdgcn_fence(__ATOMIC_RELEASE, "agent");
            asm volatile("s_waitcnt vmcnt(0)" ::: "memory");
            const unsigned og = xb_add(&bar[XB_TOP], 1u);
            const unsigned tg = og / nx;
            if (og + 1u == (tg + 1u) * nx) xb_add(&bar[XB_TOPGEN], 1u);
            else XB_SPIN(xb_ld(&bar[XB_TOPGEN]) == tg, bar);
            __builtin_amdgcn_fence(__ATOMIC_ACQUIRE, "agent");
            xb_add(&bar[XB_XGEN(b.x)], 1u);
            asm volatile("s_waitcnt vmcnt(0)" ::: "memory");
        } else {
            XB_SPIN(xb_ld(&bar[XB_XGEN(b.x)]) == gen, bar);
            __builtin_amdgcn_fence(__ATOMIC_ACQUIRE, "agent");
            asm volatile("s_waitcnt vmcnt(0)" ::: "memory");
        }
    }
    __syncthreads();
}

__device__ __forceinline__ void rownorm_row(int lane, const float* xsrc, const bf16* mrow, const float* gpost, bf16* xdst, bf16* hrow, const float* gpre) {
    f32x4 v[4];
#pragma unroll
    for (int j = 0; j < 4; ++j) v[j] = *(const f32x4*)(xsrc + 4 * lane + 256 * j);
    if (mrow) {
        f32x4 mm[4]; float ss = 0.f;
#pragma unroll
        for (int j = 0; j < 4; ++j) { const v2u w = *(const v2u*)(mrow + 4 * lane + 256 * j); mm[j] = (f32x4){bflo(w.x), bfhi(w.x), bflo(w.y), bfhi(w.y)};
            ss += (mm[j].x * mm[j].x + mm[j].y * mm[j].y) + (mm[j].z * mm[j].z + mm[j].w * mm[j].w); }
        const float r = __builtin_amdgcn_rsqf(wave_sum(ss, lane) * (1.f / DMODEL) + EPSN);
#pragma unroll
        for (int j = 0; j < 4; ++j) { const f32x4 g = *(const f32x4*)(gpost + 4 * lane + 256 * j); v[j] = v[j] + (mm[j] * r) * g; }
    }
#pragma unroll
    for (int j = 0; j < 4; ++j) { v2u w; w.x = pk2(v[j].x, v[j].y); w.y = pk2(v[j].z, v[j].w); *(v2u*)(xdst + 4 * lane + 256 * j) = w; }
    if (gpre) {
        float ss = 0.f;
#pragma unroll
        for (int j = 0; j < 4; ++j) ss += (v[j].x * v[j].x + v[j].y * v[j].y) + (v[j].z * v[j].z + v[j].w * v[j].w);
        const float r = __builtin_amdgcn_rsqf(wave_sum(ss, lane) * (1.f / DMODEL) + EPSN);
#pragma unroll
        for (int j = 0; j < 4; ++j) { const f32x4 g = *(const f32x4*)(gpre + 4 * lane + 256 * j); const f32x4 o = (v[j] * r) * g;
            v2u w; w.x = pk2(o.x, o.y); w.y = pk2(o.z, o.w); *(v2u*)(hrow + 4 * lane + 256 * j) = w; }
    }
}

__device__ __forceinline__ void rownorm_pass(int lane, int gw, int NGW, bf16* XB, const bf16* MB, const float* gpost, float* RS, float* OUT) {
    f32x4 gp[4];
#pragma unroll
    for (int j = 0; j < 4; ++j) gp[j] = *(const f32x4*)(gpost + 4 * lane + 256 * j);
    v2u nx[4], nm[4];
    int row = gw;
    if (row < MTOK) {
#pragma unroll
        for (int j = 0; j < 4; ++j) { nx[j] = *(const v2u*)(XB + (size_t)row * DMODEL + 4 * lane + 256 * j); nm[j] = __builtin_nontemporal_load((const v2u*)(MB + (size_t)row * DMODEL + 4 * lane + 256 * j)); }
    }
    while (row < MTOK) {
        v2u xw[4], w[4];
#pragma unroll
        for (int j = 0; j < 4; ++j) { xw[j] = nx[j]; w[j] = nm[j]; }
        const int nrow = row + NGW;
        if (nrow < MTOK) {
#pragma unroll
            for (int j = 0; j < 4; ++j) { nx[j] = *(const v2u*)(XB + (size_t)nrow * DMODEL + 4 * lane + 256 * j); nm[j] = __builtin_nontemporal_load((const v2u*)(MB + (size_t)nrow * DMODEL + 4 * lane + 256 * j)); }
        }
        f32x4 v[4], mm[4]; float ss = 0.f;
#pragma unroll
        for (int j = 0; j < 4; ++j) { mm[j] = (f32x4){bflo(w[j].x), bfhi(w[j].x), bflo(w[j].y), bfhi(w[j].y)}; v[j] = (f32x4){bflo(xw[j].x), bfhi(xw[j].x), bflo(xw[j].y), bfhi(xw[j].y)};
            ss += (mm[j].x * mm[j].x + mm[j].y * mm[j].y) + (mm[j].z * mm[j].z + mm[j].w * mm[j].w); }
        const float r = __builtin_amdgcn_rsqf(wave_sum(ss, lane) * (1.f / DMODEL) + EPSN);
        float s2 = 0.f;
#pragma unroll
        for (int j = 0; j < 4; ++j) { v[j] = v[j] + (mm[j] * r) * gp[j]; s2 += (v[j].x * v[j].x + v[j].y * v[j].y) + (v[j].z * v[j].z + v[j].w * v[j].w); }
        if (OUT) {
#pragma unroll
            for (int j = 0; j < 4; ++j) *(f32x4*)(OUT + (size_t)row * DMODEL + 4 * lane + 256 * j) = v[j];
        } else {
#pragma unroll
            for (int j = 0; j < 4; ++j) { v2u q; q.x = pk2(v[j].x, v[j].y); q.y = pk2(v[j].z, v[j].w); *(v2u*)(XB + (size_t)row * DMODEL + 4 * lane + 256 * j) = q; }
        }
        if (RS) { const float r2 = __builtin_amdgcn_rsqf(wave_sum(s2, lane) * (1.f / DMODEL) + EPSN); if (lane == 0) RS[row] = r2; }
        row = nrow;
    }
}

struct Args { const float* in[15]; float* out; unsigned char* ws; };
template <int OFF> __device__ __forceinline__ __attribute__((address_space(1))) void* karg() { __attribute__((address_space(1))) void* p; asm volatile("s_load_dwordx2 %0, %1, %2\n\ts_waitcnt lgkmcnt(0)" : "=s"(p) : "s"(__builtin_amdgcn_kernarg_segment_ptr()), "n"(OFF)); return p; }
#define ARG_IN(i) ((const float*)karg<8 * (i)>())
#define ARG_OUT() ((float*)karg<120>())
#define ARG_WS() ((unsigned char*)karg<128>())
#define P_X() float* const X = ARG_OUT()
#define P_WS(name, off) bf16* const name = (bf16*)(ARG_WS() + (off))

__device__ __forceinline__ v4u prep_compute(const v4u rw, const f32x4 (&tb)[4], int type, int sub, const float* qkg) {
    const bool isA = type < 2;
    const float cc[8] = {tb[0].x, tb[0].z, tb[1].x, tb[1].z, tb[2].x, tb[2].z, tb[3].x, tb[3].z};
    const float sn[8] = {tb[0].y, tb[0].w, tb[1].y, tb[1].w, tb[2].y, tb[2].w, tb[3].y, tb[3].w};
    float v[8] = {bflo(rw.x), bfhi(rw.x), bflo(rw.y), bfhi(rw.y), bflo(rw.z), bfhi(rw.z), bflo(rw.w), bfhi(rw.w)};
    float ss = 0.f;
#pragma unroll
    for (int i = 0; i < 8; ++i) ss += v[i] * v[i];
    ss = sum8(ss);
    const float rn = isA ? __builtin_amdgcn_rsqf(ss * (1.f / 64.f) + EPSN) : 1.f;
    const float* gp = qkg + (type & 1) * 64 + 8 * sub;
#pragma unroll
    for (int i = 0; i < 8; ++i) v[i] = isA ? (v[i] * rn) * gp[i] : v[i];
    const bool active = isA || sub < 2;
    const float sg = (isA ? (sub & 2) : (sub & 1)) ? 1.f : -1.f;
#pragma unroll
    for (int i = 0; i < 8; ++i) {
        const float p1 = dppf<DPP_XOR1>(v[i]), p2 = dppf<DPP_XOR2>(v[i]);
        const float pr = isA ? p2 : p1;
        const float rv = v[i] * cc[i] + sg * (pr * sn[i]);
        v[i] = active ? rv : v[i];
    }
    v4u o; o.x = pk2(v[0], v[1]); o.y = pk2(v[2], v[3]); o.z = pk2(v[4], v[5]); o.w = pk2(v[6], v[7]);
    return o;
}
struct PrepOrder : pg8::StaticOrder {
    int even, l2;
    __device__ __forceinline__ void done(const pg8::Unit& u) const {
        const int colt = u.pn * 256;
        if (even ? !(colt == 512 || colt == 1280 || colt == 1536) : (colt != 1024)) return;
        asm volatile("s_waitcnt vmcnt(0)" ::: "memory");
        __builtin_amdgcn_s_barrier();
        asm volatile("" ::: "memory");
        int tid_ = threadIdx.x; asm volatile("" : "+v"(tid_));
        const int sub = tid_ & 7, gidx = tid_ >> 3;
        unsigned char* const ws = ARG_WS(); bf16* const QKV = (bf16*)(ws + WS_QKV); const f32x2* const ropeT = (const f32x2*)(ws + WS_ROPE); const f32x2* const axT = (const f32x2*)(ws + WS_AX);
        const float* const qkg = ARG_IN(4) + (size_t)l2 * 128;
        const int PITCH = nN * 256;
        const int nh = (even && colt == 512) ? 2 : 4;
        const int nit = (256 * nh) / 64;
        constexpr int U = 4;
#pragma unroll 1
        for (int it = 0; it < nit; it += U) {
            bf16* p[U]; int type[U]; v4u raw[U]; f32x4 tb[U][4];
#pragma unroll
            for (int k = 0; k < U; ++k) {
                const int hvi = (it + k) * 64 + gidx, rl = (nh == 2) ? (hvi >> 1) : (hvi >> 2), col = colt + 64 * ((nh == 2) ? (hvi & 1) : (hvi & 3)), row = u.pm * 256 + rl;
                const int ty = (even && colt == 512) ? 1 : 3;
                type[k] = ty; p[k] = QKV + (size_t)row * PITCH + col + 8 * sub;
                raw[k] = *(const v4u*)p[k];
                const int t = row < MP ? (row & 8191) : (row & 4095);
                const int aidx = (sub < 4) ? (t >> 6) : (t & 63);
                const f32x2* cs = (ty < 2) ? axT + aidx * 16 + 8 * (sub & 1) : ropeT + t * 8;
                tb[k][0] = *(const f32x4*)(cs); tb[k][1] = *(const f32x4*)(cs + 2); tb[k][2] = *(const f32x4*)(cs + 4); tb[k][3] = *(const f32x4*)(cs + 6);
            }
#pragma unroll
            for (int k = 0; k < U; ++k) *(v4u*)p[k] = prep_compute(raw[k], tb[k], type[k], sub, qkg);
        }
        asm volatile("s_waitcnt vmcnt(0)" ::: "memory");
    }
};

__global__ void __launch_bounds__(NWAVES * 64, 2) encoder_fwd(Args args) {
    extern __shared__ __attribute__((aligned(16))) unsigned char lds[];
    cg::grid_group grid = cg::this_grid();
    LAS unsigned char* const ldsb = (LAS unsigned char*)lds;
    if (threadIdx.x < 32) ((volatile LAS unsigned*)(ldsb + 131072 + 320))[threadIdx.x] = 0u;
    __syncthreads();
#define XBAR() do { XcdBarrier b_; b_.bar = (unsigned*)(ARG_WS() + WS_BAR); b_.x = xb_xcc_id(); b_.st = (volatile LAS unsigned*)(ldsb + 131072 + 320) + 8; xcd_barrier(b_); } while (0)
#define PHASE_IDS() int tid__ = threadIdx.x; asm volatile("" : "+v"(tid__)); const int lane = tid__ & 63; const int wave = __builtin_amdgcn_readfirstlane(tid__ >> 6); \
    int G__ = gridDim.x; asm volatile("" : "+s"(G__)); const int G = G__; const int bx__ = blockIdx.x; const int vcu = (G % 8 == 0) ? (bx__ % 8) * (G / 8) + bx__ / 8 : bx__; \
    const int gw = vcu * NWAVES + wave, NGW = G * NWAVES; (void)lane; (void)gw; (void)NGW; (void)wave

    {
        PHASE_IDS();
        if (blockIdx.x == 0) { unsigned* const bw = (unsigned*)(ARG_WS() + WS_BAR); for (int i = threadIdx.x; i < 4096; i += NWAVES * 64) __hip_atomic_store(bw + i, 0u, __ATOMIC_RELAXED, __HIP_MEMORY_SCOPE_AGENT); }
        LAS float* scr = (LAS float*)(ldsb + wave * 16384);
        unsigned char* const ws = ARG_WS(); bf16* const XB = (bf16*)(ws + WS_XB);
        f32x2* const ropeT = (f32x2*)(ws + WS_ROPE); f32x2* const axT = (f32x2*)(ws + WS_AX);
        bf16* const WinE = (bf16*)(ws + WS_WINE); bf16* const WoutE = (bf16*)(ws + WS_WOUTE); bf16* const WinO = (bf16*)(ws + WS_WINO); bf16* const WoutO = (bf16*)(ws + WS_WOUTO);
        bf16* const Wgu = (bf16*)(ws + WS_WGU); bf16* const Wdn = (bf16*)(ws + WS_WDN); bf16* const H = (bf16*)(ws + WS_H);
        constexpr int I_INE = 16 * 72, I_SQ = 16 * 32, I_INO = 16 * 48, I_GU = 16 * 176, I_DN = 44 * 32;
        constexpr int NITEMS = 2 * I_INE + 2 * I_SQ + 2 * I_INO + 2 * I_SQ + 4 * I_GU + 4 * I_DN;
        for (int it = gw; it < NITEMS; it += NGW) {
            int r = it;
            if (r < 2 * I_INE) { const int l = r / I_INE; r -= l * I_INE; transpose_item(ARG_IN(2) + (size_t)l * 1024 * EVEN_IN, 1024, EVEN_IN, WinE + (size_t)l * EVEN_IN * 1024, 0, scr, r, lane, ARG_IN(11) + (2 * l) * DMODEL); continue; } r -= 2 * I_INE;
            if (r < 2 * I_SQ) { const int l = r / I_SQ; r -= l * I_SQ; transpose_item(ARG_IN(3) + (size_t)l * 1024 * 1024, 1024, 1024, WoutE + (size_t)l * 1024 * 1024, 0, scr, r, lane, nullptr); continue; } r -= 2 * I_SQ;
            if (r < 2 * I_INO) { const int l = r / I_INO; r -= l * I_INO; transpose_item(ARG_IN(6) + (size_t)l * 1024 * ODD_IN, 1024, ODD_IN, WinO + (size_t)l * ODD_IN * 1024, 0, scr, r, lane, ARG_IN(11) + (2 * l + 1) * DMODEL); continue; } r -= 2 * I_INO;
            if (r < 2 * I_SQ) { const int l = r / I_SQ; r -= l * I_SQ; transpose_item(ARG_IN(7) + (size_t)l * 1024 * 1024, 1024, 1024, WoutO + (size_t)l * 1024 * 1024, 0, scr, r, lane, nullptr); continue; } r -= 2 * I_SQ;
            if (r < 4 * I_GU) { const int l = r / I_GU; r -= l * I_GU; transpose_item(ARG_IN(9) + (size_t)l * 1024 * GU, 1024, GU, Wgu + (size_t)l * GU * 1024, 1, scr, r, lane, ARG_IN(13) + l * DMODEL); continue; } r -= 4 * I_GU;
            { const int l = r / I_DN; r -= l * I_DN; transpose_item(ARG_IN(10) + (size_t)l * FFH * 1024, FFH, 1024, Wdn + (size_t)l * 1024 * FFH, 0, scr, r, lane, nullptr); }
        }
        for (int i = gw * 64 + lane; i < 8192 * 8 + 128 * 16; i += NGW * 64) {
            float ang;
            if (i < 65536) ang = (float)(i >> 3) * ROPE_INV[i & 7]; else ang = (float)((i - 65536) >> 4) * AX_INV[(i - 65536) & 15];
            const f32x2 cs = cossin(ang);
            if (i < 65536) ropeT[i] = cs; else axT[i - 65536] = cs;
        }
        const float* const xin0 = ARG_IN(0); const float* const xin1 = ARG_IN(1); float* const RS = (float*)(ws + WS_RS);
        for (int row = gw; row < MTOK; row += NGW) {
            const float* src = row < MP ? xin0 + (size_t)row * DMODEL : xin1 + (size_t)(row - MP) * DMODEL;
            f32x4 v[4]; float ss = 0.f;
#pragma unroll
            for (int j = 0; j < 4; ++j) { v[j] = __builtin_nontemporal_load((const f32x4*)(src + 4 * lane + 256 * j)); ss += (v[j].x * v[j].x + v[j].y * v[j].y) + (v[j].z * v[j].z + v[j].w * v[j].w); }
#pragma unroll
            for (int j = 0; j < 4; ++j) { v2u w; w.x = pk2(v[j].x, v[j].y); w.y = pk2(v[j].z, v[j].w); *(v2u*)(XB + (size_t)row * DMODEL + 4 * lane + 256 * j) = w; }
            const float r = __builtin_amdgcn_rsqf(wave_sum(ss, lane) * (1.f / DMODEL) + EPSN);
            if (lane == 0) RS[row] = r;
        }
    }
    grid.sync();
    { (void)xcd_barrier_post((unsigned*)(ARG_WS() + WS_BAR), (volatile LAS unsigned*)(ldsb + 131072 + 320) + 8); }

#pragma unroll 1
    for (int l = 0; l < 4; ++l) {
        const int l2 = l >> 1; const bool even = (l & 1) == 0;
        {
            const int NIN = even ? EVEN_IN : ODD_IN;
            unsigned char* const ws = ARG_WS(); const bf16* const H = (const bf16*)(ws + WS_XB); bf16* const QKV = (bf16*)(ws + WS_QKV); const float* const RS = (const float*)(ws + WS_RS);
            const bf16* const WinE = (const bf16*)(ws + WS_WINE); const bf16* const WinO = (const bf16*)(ws + WS_WINO);
            const bf16* Wt = even ? WinE + (size_t)l2 * EVEN_IN * 1024 : WinO + (size_t)l2 * ODD_IN * 1024;
            pg8::Gemm g{H, Wt, MTOK, NIN, 1024}; PrepOrder S; S.init(MTOK, NIN, (int)gridDim.x, (int)blockIdx.x); S.even = even ? 1 : 0; S.l2 = l2;
            pg8::EpiBf16<true> E{QKV, NIN, RS};
#ifndef NO_GEMM1
            pg8::gemm_phase<pg8::EpiBf16<true>, PrepOrder, PG8_ALIGN, PG8_SP2>(ldsb, g, S, E);
#endif
        }
        XBAR();
        if (even) {
            PHASE_IDS();
            unsigned char* const ws = ARG_WS(); bf16* const QKV = (bf16*)(ws + WS_QKV); bf16* const ATT = (bf16*)(ws + WS_ATT); bf16* const OB = (bf16*)(ws + WS_OB);
            const f32x2* const ropeT = (const f32x2*)(ws + WS_ROPE); const f32x2* const axT = (const f32x2*)(ws + WS_AX); const float* const qgainA = ARG_IN(4) + (size_t)l2 * 128;
#ifndef NO_ATT_E
#define DEC_E(u_, sb_, S_, h_, qb_) do { if ((u_) < 2048) { const int s_ = (u_) >> 8, rem_ = (u_) & 255; h_ = rem_ >> 5; qb_ = rem_ & 31; S_ = 8192; sb_ = s_ * 8192; } \
                else { const int u2_ = (u_) - 2048; const int s_ = u2_ >> 7, rem_ = u2_ & 127; h_ = rem_ >> 4; qb_ = rem_ & 15; S_ = 4096; sb_ = MP + s_ * 4096; } } while (0)
            { int b0 = 0; bool pre = false;
            for (int u = vcu; u < 2048 + 512; u += G) {
                int sb, S, vh, qb; DEC_E(u, sb, S, vh, qb);
                const int q0 = qb * 256;
                const attn_body::bf16 *nK = nullptr, *nV = nullptr;
                if (u + G < 2048 + 512) { int sbn, Sn, vhn, qbn; DEC_E(u + G, sbn, Sn, vhn, qbn); nK = (const attn_body::bf16*)(QKV + (size_t)sbn * EVEN_IN + 512 + 64 * (vhn >> 2)); nV = (const attn_body::bf16*)(QKV + (size_t)sbn * EVEN_IN + 640 + 64 * (vhn >> 2)); }
                attn_body::attn_unit<8, false, EVEN_IN, 1024, 64, 1>((const attn_body::bf16*)(QKV + (size_t)(sb + q0) * EVEN_IN + 64 * vh), (const attn_body::bf16*)(QKV + (size_t)sb * EVEN_IN + 512 + 64 * (vh >> 2)),
                    (const attn_body::bf16*)(QKV + (size_t)sb * EVEN_IN + 640 + 64 * (vh >> 2)), (attn_body::bf16*)(ATT + (size_t)(sb + q0) * 1024 + 64 * vh), q0, 0, S / 64, 0.f, (char*)lds, qgainA, (const float*)axT, b0, pre, nK, nV);
                b0 = (b0 + S / 64) % 3; pre = (nK != nullptr);
            } }
            { int b0 = 0; bool pre = false;
            const float lam_init = (l == 0) ? 0.2f : 0.4707130183435842f;
            float lam;
            { const float* lf = ARG_IN(5) + (size_t)l2 * 256;
              const float sa = wave_sum(lf[lane] * lf[64 + lane], lane), sb2 = wave_sum(lf[128 + lane] * lf[192 + lane], lane);
              lam = __builtin_bit_cast(float, __builtin_amdgcn_readfirstlane(__builtin_bit_cast(int, __expf(sa) - __expf(sb2) + lam_init))); }
#define DEC_P(p_, sb_, S_, h_, qb_) do { if ((p_) < 1024) { const int s_ = (p_) >> 7, rem_ = (p_) & 127; h_ = rem_ >> 5; qb_ = rem_ & 31; S_ = 8192; sb_ = s_ * 8192; } \
                else { const int p2_ = (p_) - 1024; const int s_ = p2_ >> 6, rem_ = p2_ & 63; h_ = rem_ >> 4; qb_ = rem_ & 15; S_ = 4096; sb_ = MP + s_ * 4096; } } while (0)
            for (int p = vcu; p < 1024 + 256; p += G) {
                int sb, S, h, qb; DEC_P(p, sb, S, h, qb);
                const int q0 = qb * 256;
                const attn_body::bf16 *pK = nullptr, *pV = nullptr;
                if (p + G < 1024 + 256) { int sbn, Sn, hn, qbn; DEC_P(p + G, sbn, Sn, hn, qbn); pK = (const attn_body::bf16*)(QKV + (size_t)sbn * EVEN_IN + 1280 + 128 * hn); pV = (const attn_body::bf16*)(QKV + (size_t)sbn * EVEN_IN + 1792 + 128 * hn); }
#pragma unroll 1
                for (int m = 0; m < 2; ++m) { const int hm = 2 * h + m;
                    const attn_body::bf16* nK = (m == 0) ? (const attn_body::bf16*)(QKV + (size_t)sb * EVEN_IN + 1280 + 64 * (hm + 1)) : pK;
                    const attn_body::bf16* nV = (m == 0) ? (const attn_body::bf16*)(QKV + (size_t)sb * EVEN_IN + 1792 + 128 * h) : pV;
                    attn_body::attn_unit<8, false, EVEN_IN, 1024, 128, 2>((const attn_body::bf16*)(QKV + (size_t)(sb + q0) * EVEN_IN + 768 + 64 * hm), (const attn_body::bf16*)(QKV + (size_t)sb * EVEN_IN + 1280 + 64 * hm),
                        (const attn_body::bf16*)(QKV + (size_t)sb * EVEN_IN + 1792 + 128 * h), (attn_body::bf16*)(OB + (size_t)(sb + q0) * 1024 + 128 * hm), q0, 0, S / 64, 0.f, (char*)lds, nullptr, (const float*)ropeT, b0, pre, nK, nV);
                    b0 = (b0 + S / 64) % 3; pre = (nK != nullptr); }
                asm volatile("s_waitcnt vmcnt(0)" ::: "memory");
                __builtin_amdgcn_s_barrier();
                asm volatile("" ::: "memory");
                int ct_ = threadIdx.x; asm volatile("" : "+v"(ct_));
                const int csub = ct_ & 15, crr = ct_ >> 4;
#pragma unroll 1
                for (int b4 = 0; b4 < 8; b4 += 4) {
                    v4u a[4], b[4];
#pragma unroll
                    for (int k = 0; k < 4; ++k) { const size_t row = (size_t)(sb + q0 + (b4 + k) * 32 + crr); const bf16* p0 = OB + row * 1024 + 256 * h + 8 * csub; a[k] = __builtin_nontemporal_load((const v4u*)p0); b[k] = __builtin_nontemporal_load((const v4u*)(p0 + 128)); }
#pragma unroll
                    for (int k = 0; k < 4; ++k) { const size_t row = (size_t)(sb + q0 + (b4 + k) * 32 + crr);
                        float o[8] = {bflo(a[k].x) - lam * bflo(b[k].x), bfhi(a[k].x) - lam * bfhi(b[k].x), bflo(a[k].y) - lam * bflo(b[k].y), bfhi(a[k].y) - lam * bfhi(b[k].y),
                                      bflo(a[k].z) - lam * bflo(b[k].z), bfhi(a[k].z) - lam * bfhi(b[k].z), bflo(a[k].w) - lam * bflo(b[k].w), bfhi(a[k].w) - lam * bfhi(b[k].w)};
                        float ss = 0.f;
#pragma unroll
                        for (int i = 0; i < 8; ++i) ss += o[i] * o[i];
                        ss = sum16(ss);
                        const float r = __builtin_amdgcn_rsqf(ss * (1.f / 128.f) + EPSN) * (1.f - lam_init);
                        v4u w; w.x = pk2(o[0] * r, o[1] * r); w.y = pk2(o[2] * r, o[3] * r); w.z = pk2(o[4] * r, o[5] * r); w.w = pk2(o[6] * r, o[7] * r);
                        *(v4u*)(ATT + row * 1024 + 512 + 128 * h + 8 * csub) = w; }
                }
            } }
#undef DEC_P
#undef DEC_E
#endif
        } else {
            unsigned char* const ws = ARG_WS(); bf16* const QKV = (bf16*)(ws + WS_QKV); bf16* const ATT = (bf16*)(ws + WS_ATT); const float* const sinkp = ARG_IN(8) + l2 * 16; const f32x2* const ropeT = (const f32x2*)(ws + WS_ROPE);
            PHASE_IDS();
#define DEC_O(u_, sb_, S_, g_, q0_, klo_, khi_) do { int qb_; if ((u_) < 4096) { const int s_ = (u_) >> 9, rem_ = (u_) & 511; g_ = rem_ >> 7; qb_ = rem_ & 127; S_ = 8192; sb_ = s_ * 8192; } \
                else { const int u2_ = (u_) - 4096; const int s_ = u2_ >> 8, rem_ = u2_ & 255; g_ = rem_ >> 6; qb_ = rem_ & 63; S_ = 4096; sb_ = MP + s_ * 4096; } \
                q0_ = qb_ * 64; klo_ = q0_ >= 128 ? q0_ - 128 : 0; khi_ = (q0_ + 192 <= S_) ? q0_ + 192 : S_; \
                if (((khi_ - klo_) >> 6) & 1) { if (khi_ + 64 <= S_) khi_ += 64; else klo_ -= 64; } } while (0)
            { int b0 = 0; bool pre = false;
            for (int u = vcu; u < 4096 + 1024; u += G) {
                int sb, S, g, q0, klo, khi; DEC_O(u, sb, S, g, q0, klo, khi);
                const attn_body::bf16 *nK = nullptr, *nV = nullptr;
                if (u + G < 4096 + 1024) { int sbn, Sn, gn, q0n, klon, khin; DEC_O(u + G, sbn, Sn, gn, q0n, klon, khin);
                    nK = (const attn_body::bf16*)(QKV + (size_t)(sbn + klon) * ODD_IN + 1024 + 64 * gn); nV = (const attn_body::bf16*)(QKV + (size_t)(sbn + klon) * ODD_IN + 1280 + 64 * gn); }
#ifndef NO_ATT_O
                attn_body::attn_unit<8, true, ODD_IN, 1024, 64, 2>((const attn_body::bf16*)(QKV + (size_t)(sb + q0) * ODD_IN + 256 * g), (const attn_body::bf16*)(QKV + (size_t)sb * ODD_IN + 1024 + 64 * g),
                    (const attn_body::bf16*)(QKV + (size_t)sb * ODD_IN + 1280 + 64 * g), (attn_body::bf16*)(ATT + (size_t)(sb + q0) * 1024 + 256 * g), q0, klo >> 6, (khi - klo) >> 6, 0.f, (char*)lds, sinkp + 4 * g, (const float*)ropeT, b0, pre, nK, nV);
#endif
                b0 = (b0 + ((khi - klo) >> 6)) % 3; pre = (nK != nullptr);
            } }
#undef DEC_O
        }
        XBAR();
        {
            unsigned char* const ws = ARG_WS(); const bf16* const ATT = (const bf16*)(ws + WS_ATT); bf16* const MB = (bf16*)(ws + WS_OB);
            const bf16* Wt = (const bf16*)(ws + (even ? WS_WOUTE : WS_WOUTO)) + (size_t)l2 * 1024 * 1024;
            pg8::Gemm g{ATT, Wt, MTOK, 1024, 1024}; pg8::StaticOrder S; S.init(MTOK, 1024, (int)gridDim.x, (int)blockIdx.x);
            pg8::EpiBf16<false> E{MB, 1024, nullptr};
#ifndef NO_GEMM2
            pg8::gemm_phase<pg8::EpiBf16<false>, pg8::StaticOrder, PG8_ALIGN, PG8_SP2>(ldsb, g, S, E);
#endif
        }
        XBAR();
        {
            PHASE_IDS();
            unsigned char* const ws = ARG_WS(); bf16* const XB = (bf16*)(ws + WS_XB); const bf16* const MB = (const bf16*)(ws + WS_OB); float* const RS = (float*)(ws + WS_RS);
            const float* const gpost = ARG_IN(12) + l * DMODEL;
            rownorm_pass(lane, gw, NGW, XB, MB, gpost, RS, nullptr);
        }
        XBAR();
        {
            unsigned char* const ws = ARG_WS(); const bf16* const H = (const bf16*)(ws + WS_XB); bf16* const HID = (bf16*)(ws + WS_HID); const bf16* const Wgu = (const bf16*)(ws + WS_WGU); const float* const RS = (const float*)(ws + WS_RS);
            pg8::Gemm g{H, Wgu + (size_t)l * GU * 1024, MTOK, GU, 1024}; pg8::StaticOrder S; S.init(MTOK, GU, (int)gridDim.x, (int)blockIdx.x);
            pg8::EpiSwiGLU E{HID, FFH, RS};
#ifndef NO_GEMM3
            pg8::gemm_phase<pg8::EpiSwiGLU, pg8::StaticOrder, PG8_ALIGN, PG8_SP2>(ldsb, g, S, E);
#endif
        }
        XBAR();
        {
            unsigned char* const ws = ARG_WS(); const bf16* const HID = (const bf16*)(ws + WS_HID); bf16* const MB = (bf16*)(ws + WS_OB); const bf16* const Wdn = (const bf16*)(ws + WS_WDN);
            pg8::Gemm g{HID, Wdn + (size_t)l * 1024 * FFH, MTOK, 1024, FFH}; pg8::StaticOrder S; S.init(MTOK, 1024, (int)gridDim.x, (int)blockIdx.x);
            pg8::EpiBf16<false> E{MB, 1024, nullptr};
#ifndef NO_GEMM4
            pg8::gemm_phase<pg8::EpiBf16<false>, pg8::StaticOrder, PG8_ALIGN, PG8_SP2>(ldsb, g, S, E);
#endif
        }
        XBAR();
        {
            PHASE_IDS();
            unsigned char* const ws = ARG_WS(); bf16* const XB = (bf16*)(ws + WS_XB); const bf16* const MB = (const bf16*)(ws + WS_OB);
            float* const OUT = (l == 3) ? ARG_OUT() : nullptr; float* const RS = (l < 3) ? (float*)(ws + WS_RS) : nullptr;
            const float* const gpost = ARG_IN(14) + l * DMODEL;
            rownorm_pass(lane, gw, NGW, XB, MB, gpost, RS, OUT);
        }
        if (l < 3) XBAR();
    }
}

extern "C" void kernel_launch(void* const* d_in, const int* in_sizes, int n_in, void* d_out, int out_size, void* d_ws, size_t ws_size, hipStream_t stream) {
    static int grid = 0;
    if (grid == 0) {
        if (n_in != 15 || out_size != MTOK * DMODEL || ws_size < WS_END) { fprintf(stderr, "kernel_launch: unexpected shapes: n_in %d out %d ws %zu\n", n_in, out_size, ws_size); grid = -1; return; }
        int dev = 0, cus = 0, per_cu = 0;
        if (hipGetDevice(&dev) != hipSuccess || hipDeviceGetAttribute(&cus, hipDeviceAttributeMultiprocessorCount, dev) != hipSuccess) { grid = -1; return; }
        if (hipFuncSetAttribute((const void*)encoder_fwd, hipFuncAttributeMaxDynamicSharedMemorySize, LDS_BYTES) != hipSuccess) { fprintf(stderr, "kernel_launch: hipFuncSetAttribute failed\n"); grid = -1; return; }
        if (hipOccupancyMaxActiveBlocksPerMultiprocessor(&per_cu, (const void*)encoder_fwd, NWAVES * 64, LDS_BYTES) != hipSuccess || per_cu < 1) { fprintf(stderr, "kernel_launch: occupancy query says %d\n", per_cu); per_cu = 1; }
        (void)hipGetLastError();
        grid = cus;
    }
    if (grid < 0) return;
    Args a{};
    for (int i = 0; i < 15; ++i) a.in[i] = (const float*)d_in[i];
    a.out = (float*)d_out; a.ws = (unsigned char*)d_ws;
    void* kargs[] = {&a};
    const hipError_t e = hipLaunchCooperativeKernel((const void*)encoder_fwd, dim3(grid), dim3(NWAVES * 64), kargs, LDS_BYTES, stream);
    if (e != hipSuccess) fprintf(stderr, "kernel_launch: cooperative launch failed: %s (grid %d)\n", hipGetErrorString(e), grid);
}
```

```cpp
#include <hip/hip_runtime.h>
#include <cstdio>
#include <cstdint>
namespace pg8 {
#define PG8_LAS __attribute__((address_space(3)))
typedef unsigned short bf16_t;
typedef short bf16x8 __attribute__((ext_vector_type(8)));
typedef float f32x4 __attribute__((ext_vector_type(4)));
typedef unsigned u32x4 __attribute__((ext_vector_type(4)));
constexpr int BM = 256, BK = 64, HALF = 128, HTB = HALF * BK * 2  , STAGE_BYTES = 8 * HTB, NXCD = 8, WGM = 8;

__host__ __device__ __forceinline__ int lds_byte(int r, int c) { const int st = (r >> 4) * 2 + (c >> 5), rr = r & 15, cc = c & 31, ob = rr * 64 + cc * 2; return st * 1024 + (ob ^ (((ob >> 9) & 1) << 5)); }
__host__ __device__ __forceinline__ void stage_rc(int b, int& R, int& C) { const int st = b / 1024, sb = b % 1024, swz = sb ^ (((sb >> 9) & 1) << 5); R = (st >> 1) * 16 + swz / 64; C = (st & 1) * 32 + (swz % 64) / 2; }
__host__ __device__ __forceinline__ int perm32(int rho) { const int n = rho >> 4, i = rho & 15; return 8 * (i >> 2) + 4 * n + (i & 3); }

struct Unit { int pm, pn; };
struct Gemm { const bf16_t* A; const bf16_t* Bt; int M, N, K; };

struct StaticOrder {
    int nM, nN, nwg, G, c;
    __host__ __device__ void init(int M, int N, int G_, int c_) { nM = M / BM; nN = N / BM; nwg = nM * nN; G = G_; c = c_; }
    __host__ __device__ bool next(int i, Unit& u) const {
        const long L = (long)i * G + c; if (L >= nwg) return false;
        int wgid = (int)L; { const int q = nwg / NXCD, r = nwg % NXCD, xcd = wgid % NXCD, off = wgid / NXCD; wgid = (xcd < r ? xcd * (q + 1) : r * (q + 1) + (xcd - r) * q) + off; }
        const int nig = WGM * nN, gid = wgid / nig, fm = gid * WGM, gsz = (nM - fm) < WGM ? (nM - fm) : WGM;
        u.pm = fm + ((wgid % nig) % gsz); u.pn = (wgid % nig) / gsz; return true;
    }
    __device__ __forceinline__ void a_ready(const Unit&) const {}
    __device__ __forceinline__ void done(const Unit&) const {}
};

__device__ __forceinline__ unsigned cvt_pk_bf16(float lo, float hi) { unsigned r; asm volatile("v_cvt_pk_bf16_f32 %0, %1, %2" : "=v"(r) : "v"(lo), "v"(hi)); return r; }
typedef float f32x2 __attribute__((ext_vector_type(2)));
template <bool RSC> struct EpiBf16 {
    static constexpr bool PERM = true, AFTER_DRAIN = false, HAS_RS = RSC;
    bf16_t* O; int ldc; const float* rs;
    __device__ __forceinline__ void operator()(const f32x4 (&acc)[2][2][4][2], const Unit& u, int wr, int wc, int fr, int fq, const float (&rsv)[8]) const {
        const int row0 = u.pm * BM + wr * 64 + fr; const int col0 = u.pn * BM + wc * 32 + 8 * fq;
#pragma unroll
        for (int ai = 0; ai < 2; ++ai)
#pragma unroll
            for (int m = 0; m < 4; ++m) { bf16_t* rowp = O + (size_t)(row0 + ai * HALF + m * 16) * ldc + col0; const float sc = RSC ? rsv[4 * ai + m] : 1.f;
#pragma unroll
                for (int bj = 0; bj < 2; ++bj) { const f32x4 v0 = acc[ai][bj][m][0] * sc, v1 = acc[ai][bj][m][1] * sc;
                    u32x4 w; w.x = cvt_pk_bf16(v0[0], v0[1]); w.y = cvt_pk_bf16(v0[2], v0[3]); w.z = cvt_pk_bf16(v1[0], v1[1]); w.w = cvt_pk_bf16(v1[2], v1[3]);
                    *(u32x4*)(rowp + bj * HALF) = w; } }
    }
};
__device__ __forceinline__ float silu_mul(float g, float u) { const float e = __builtin_amdgcn_exp2f(g * -1.4426950408889634f); return g * __builtin_amdgcn_rcpf(1.0f + e) * u; }
struct EpiSwiGLU {
    static constexpr bool PERM = true, AFTER_DRAIN = false, HAS_RS = true;
    bf16_t* O; int ldc; const float* rs;
    __device__ __forceinline__ void operator()(const f32x4 (&acc)[2][2][4][2], const Unit& u, int wr, int wc, int fr, int fq, const float (&rsv)[8]) const {
        const int row0 = u.pm * BM + wr * 64 + fr; const int col0 = u.pn * HALF + wc * 32 + 8 * fq;
#pragma unroll
        for (int ai = 0; ai < 2; ++ai)
#pragma unroll
            for (int m = 0; m < 4; ++m) { bf16_t* rowp = O + (size_t)(row0 + ai * HALF + m * 16) * ldc + col0;
                const float sc = rsv[4 * ai + m];
                const f32x4 g0 = acc[ai][0][m][0] * sc, g1 = acc[ai][0][m][1] * sc, u0 = acc[ai][1][m][0] * sc, u1 = acc[ai][1][m][1] * sc;
                u32x4 w; w.x = cvt_pk_bf16(silu_mul(g0[0], u0[0]), silu_mul(g0[1], u0[1])); w.y = cvt_pk_bf16(silu_mul(g0[2], u0[2]), silu_mul(g0[3], u0[3]));
                w.z = cvt_pk_bf16(silu_mul(g1[0], u1[0]), silu_mul(g1[1], u1[1])); w.w = cvt_pk_bf16(silu_mul(g1[2], u1[2]), silu_mul(g1[3], u1[3]));
                *(u32x4*)rowp = w; }
    }
};

template <class Epi, class Sched, bool ALIGN_EPI = false, bool SP2 = false>
__device__ __forceinline__ void gemm_phase(PG8_LAS unsigned char* lds, const Gemm g, const Sched& S, const Epi& E) {
    int tid_ = threadIdx.x; asm volatile("" : "+v"(tid_));
    const int tid = tid_, wid = __builtin_amdgcn_readfirstlane(tid >> 6), lane = tid & 63, wr = wid >> 2, wc = wid & 3, fr = lane & 15, fq = lane >> 4;
    const int K = g.K, nt = K / BK;
    unsigned voffA[2], voffB[2];
#pragma unroll
    for (int i = 0; i < 2; ++i) { int R, C; stage_rc(tid * 16 + i * 8192, R, C); const int Rb = Epi::PERM ? ((R & ~31) + perm32(R & 31)) : R;
        voffA[i] = (unsigned)(R * K + C) * 2u; voffB[i] = (unsigned)(Rb * K + C) * 2u; }
    const size_t kstep = (size_t)(BK * 2);
    const size_t hstep = (size_t)HALF * K * 2;
    const size_t tstep = 2 * hstep;
    const unsigned ldsw = (unsigned)wid * 1024u;
    const int aoff = lds_byte(wr * 64 + fr, fq * 8), boff = lds_byte(wc * 32 + fr, fq * 8);
#define PG8_SA(b, h) (((b) * 2 + (h)) * HTB)
#define PG8_SB(b, h) ((4 + (b) * 2 + (h)) * HTB)
#define PG8_STAGE(bufoff, gbase, voff) do { _Pragma("unroll") for (int _i = 0; _i < 2; ++_i) \
        __builtin_amdgcn_global_load_lds((const unsigned*)((const char*)(gbase) + (voff)[_i]), (PG8_LAS unsigned*)(lds + (bufoff) + ldsw + _i * 8192), 16, 0, 0); } while (0)
#define PG8_LDA(dst, b, h) do { _Pragma("unroll") for (int m = 0; m < 4; ++m) _Pragma("unroll") for (int k = 0; k < 2; ++k) dst[m][k] = *(const PG8_LAS bf16x8*)(lds + PG8_SA(b, h) + aoff + m * 2048 + k * 1024); } while (0)
#define PG8_LDB(dst, b, h) do { _Pragma("unroll") for (int n = 0; n < 2; ++n) _Pragma("unroll") for (int k = 0; k < 2; ++k) dst[n][k] = *(const PG8_LAS bf16x8*)(lds + PG8_SB(b, h) + boff + n * 2048 + k * 1024); } while (0)
#define PG8_MMA(ai, bj, At, Bt) do { __builtin_amdgcn_s_setprio(1); _Pragma("unroll") for (int m = 0; m < 4; ++m) _Pragma("unroll") for (int n = 0; n < 2; ++n) _Pragma("unroll") for (int k = 0; k < 2; ++k) \
        acc[ai][bj][m][n] = __builtin_amdgcn_mfma_f32_16x16x32_bf16(Bt[n][k], At[m][k], acc[ai][bj][m][n], 0, 0, 0); __builtin_amdgcn_s_setprio(0); } while (0)
#define PG8_WAIT_V(n) asm volatile("s_waitcnt vmcnt(" #n ")" ::: "memory")
#define PG8_WAIT_L(n) asm volatile("s_waitcnt lgkmcnt(" #n ")" ::: "memory")
#define PG8_BAR __builtin_amdgcn_s_barrier()
#define PG8_SCHED __builtin_amdgcn_sched_barrier(0)
    Unit cur, nxt; int ui = 0;
    if (!S.next(0, cur)) return;
    f32x4 acc[2][2][4][2];
#pragma unroll
    for (int a = 0; a < 2; ++a)
#pragma unroll
        for (int b = 0; b < 2; ++b)
#pragma unroll
            for (int m = 0; m < 4; ++m)
#pragma unroll
                for (int n = 0; n < 2; ++n) acc[a][b][m][n] = (f32x4){0.f, 0.f, 0.f, 0.f};
    bf16x8 At[4][2], B0[2][2], B1[2][2];
    float rsv[8] = {1.f, 1.f, 1.f, 1.f, 1.f, 1.f, 1.f, 1.f};
    const char* cA = (const char*)g.A + (size_t)cur.pm * tstep; const char* cB = (const char*)g.Bt + (size_t)cur.pn * tstep;
    S.a_ready(cur);
    if constexpr (SP2) {
        PG8_STAGE(PG8_SB(0, 0), cB, voffB); PG8_STAGE(PG8_SB(0, 1), cB + hstep, voffB); PG8_STAGE(PG8_SA(0, 0), cA, voffA); PG8_STAGE(PG8_SA(0, 1), cA + hstep, voffA);
        if (wr == 1) PG8_BAR;
        PG8_WAIT_V(2); PG8_BAR;
        PG8_STAGE(PG8_SB(1, 0), cB + kstep, voffB); PG8_STAGE(PG8_SA(1, 0), cA + kstep, voffA); PG8_STAGE(PG8_SB(1, 1), cB + hstep + kstep, voffB);
        PG8_WAIT_V(6); PG8_BAR;
    } else {
        PG8_STAGE(PG8_SB(0, 0), cB, voffB); PG8_STAGE(PG8_SA(0, 0), cA, voffA); PG8_STAGE(PG8_SB(0, 1), cB + hstep, voffB); PG8_STAGE(PG8_SA(0, 1), cA + hstep, voffA);
        if (wr == 1) PG8_BAR;
        PG8_WAIT_V(4); PG8_BAR;
        PG8_STAGE(PG8_SB(1, 0), cB + kstep, voffB); PG8_STAGE(PG8_SA(1, 0), cA + kstep, voffA); PG8_STAGE(PG8_SB(1, 1), cB + hstep + kstep, voffB);
        PG8_WAIT_V(6); PG8_BAR;
    }
    for (;;) {
        const bool has_next = S.next(ui + 1, nxt);
        const char* nA = has_next ? (const char*)g.A + (size_t)nxt.pm * tstep : cA; const char* nB = has_next ? (const char*)g.Bt + (size_t)nxt.pn * tstep : cB;
        for (int t = 0; t < nt; t += 2) {
            const bool last = (t == nt - 2);
            if constexpr (Epi::HAS_RS) { if (last) {
                const int r0_ = cur.pm * BM + wr * 64 + fr;
                _Pragma("unroll") for (int ai_ = 0; ai_ < 2; ++ai_) _Pragma("unroll") for (int m_ = 0; m_ < 4; ++m_) rsv[4 * ai_ + m_] = E.rs[r0_ + ai_ * HALF + m_ * 16]; } }
            const char* a1 = cA + (size_t)(t + 1) * kstep;
            const char* a2 = last ? nA : cA + (size_t)(t + 2) * kstep; const char* b2 = last ? nB : cB + (size_t)(t + 2) * kstep;
            const char* a3 = a2 + kstep; const char* b3 = b2 + kstep;
            if (last && has_next) S.a_ready(nxt);
            if constexpr (SP2) {
            PG8_LDB(B0, 0, 0); PG8_LDB(B1, 0, 1); PG8_SCHED; PG8_LDA(At, 0, 0); PG8_STAGE(PG8_SA(1, 1), a1 + hstep, voffA);
            PG8_WAIT_V(8); PG8_WAIT_L(0); PG8_BAR; PG8_MMA(0, 0, At, B0); PG8_MMA(0, 1, At, B1); PG8_BAR; PG8_SCHED;
            PG8_LDA(At, 0, 1); PG8_STAGE(PG8_SB(0, 0), b2, voffB); PG8_STAGE(PG8_SB(0, 1), b2 + hstep, voffB); PG8_STAGE(PG8_SA(0, 0), a2, voffA);
            PG8_WAIT_V(8); PG8_WAIT_L(0); PG8_BAR; PG8_MMA(1, 0, At, B0); PG8_MMA(1, 1, At, B1); PG8_BAR; PG8_SCHED;
            PG8_LDB(B0, 1, 0); PG8_LDB(B1, 1, 1); PG8_SCHED; PG8_LDA(At, 1, 0); PG8_STAGE(PG8_SA(0, 1), a2 + hstep, voffA);
            PG8_WAIT_V(8); PG8_WAIT_L(0); PG8_BAR; PG8_MMA(0, 0, At, B0); PG8_MMA(0, 1, At, B1); PG8_BAR; PG8_SCHED;
            PG8_LDA(At, 1, 1); PG8_STAGE(PG8_SB(1, 0), b3, voffB); PG8_STAGE(PG8_SB(1, 1), b3 + hstep, voffB); PG8_STAGE(PG8_SA(1, 0), a3, voffA);
            PG8_WAIT_V(8); PG8_WAIT_L(0); PG8_BAR; PG8_MMA(1, 0, At, B0); PG8_MMA(1, 1, At, B1); PG8_BAR; PG8_SCHED;
            } else {
            PG8_LDB(B0, 0, 0); PG8_SCHED; PG8_LDA(At, 0, 0); PG8_STAGE(PG8_SA(1, 1), a1 + hstep, voffA);
            PG8_WAIT_L(8); PG8_BAR; PG8_WAIT_L(0); PG8_MMA(0, 0, At, B0); PG8_BAR; PG8_SCHED;
            PG8_LDB(B1, 0, 1); PG8_STAGE(PG8_SB(0, 0), b2, voffB);
            PG8_BAR; PG8_WAIT_L(0); PG8_MMA(0, 1, At, B1); PG8_BAR;
            PG8_LDA(At, 0, 1); PG8_STAGE(PG8_SA(0, 0), a2, voffA);
            PG8_BAR; PG8_WAIT_L(0); PG8_MMA(1, 0, At, B0); PG8_BAR; PG8_SCHED;
            PG8_STAGE(PG8_SB(0, 1), b2 + hstep, voffB);
            PG8_WAIT_V(6); PG8_BAR; PG8_MMA(1, 1, At, B1); PG8_BAR;
            PG8_LDB(B0, 1, 0); PG8_SCHED; PG8_LDA(At, 1, 0); PG8_STAGE(PG8_SA(0, 1), a2 + hstep, voffA);
            PG8_WAIT_L(8); PG8_BAR; PG8_WAIT_L(0); PG8_MMA(0, 0, At, B0); PG8_BAR; PG8_SCHED;
            PG8_LDB(B1, 1, 1); PG8_STAGE(PG8_SB(1, 0), b3, voffB);
            PG8_BAR; PG8_WAIT_L(0); PG8_MMA(0, 1, At, B1); PG8_BAR;
            PG8_LDA(At, 1, 1); PG8_STAGE(PG8_SA(1, 0), a3, voffA);
            PG8_BAR; PG8_WAIT_L(0); PG8_MMA(1, 0, At, B0); PG8_BAR; PG8_SCHED;
            PG8_STAGE(PG8_SB(1, 1), b3 + hstep, voffB);
            PG8_WAIT_V(6); PG8_BAR; PG8_MMA(1, 1, At, B1); PG8_BAR;
            }
        }
        if constexpr (ALIGN_EPI) { if (wr == 0) PG8_BAR; }
        if constexpr (!Epi::AFTER_DRAIN) { E(acc, cur, wr, wc, fr, fq, rsv); S.done(cur); }
        if (!has_next) break;
#pragma unroll
        for (int a = 0; a < 2; ++a)
#pragma unroll
            for (int b = 0; b < 2; ++b)
#pragma unroll
                for (int m = 0; m < 4; ++m)
#pragma unroll
                    for (int n = 0; n < 2; ++n) acc[a][b][m][n] = (f32x4){0.f, 0.f, 0.f, 0.f};
        cur = nxt; cA = nA; cB = nB; ++ui;
        if constexpr (ALIGN_EPI) { if (wr == 1) PG8_BAR; }
    }
    PG8_WAIT_V(0);
    if constexpr (!ALIGN_EPI) { if (wr == 0) PG8_BAR; }
    PG8_BAR;
    if constexpr (Epi::AFTER_DRAIN) { E.fused(acc, cur, wr, wc, fr, fq, lds, wid, lane); S.done(cur); }
#undef PG8_SA
#undef PG8_SB
#undef PG8_STAGE
#undef PG8_LDA
#undef PG8_LDB
#undef PG8_MMA
#undef PG8_WAIT_V
#undef PG8_WAIT_L
#undef PG8_BAR
#undef PG8_SCHED
}
}

#ifndef PG8_SP2
#define PG8_SP2 true
#endif
#ifndef PG8_ALIGN
#define PG8_ALIGN true
#endif
#include <hip/hip_bf16.h>
#include <cmath>
namespace attn_body {
using bf16=__hip_bfloat16;
using bf16x8=__attribute__((ext_vector_type(8)))short;
using s16x4=__attribute__((ext_vector_type(4)))short;
using f32x16=__attribute__((ext_vector_type(16)))float;
using u32x4=__attribute__((ext_vector_type(4)))unsigned;
constexpr int D=64;
constexpr int NW=8,QBLK=32,QB=QBLK*NW,KVBLK=64;
constexpr int ATTN_UNIT_ROWS=QB;
__device__ __forceinline__ int crow(int r,int hi){return (r&3)+8*(r>>2)+4*hi;}
#define SBAR() __builtin_amdgcn_sched_barrier(0)
__device__ __forceinline__ void wmask(f32x16&p0,f32x16&p1,int kb,int qpos){
  const float NEG=-INFINITY; const int d0=kb-qpos;
  #pragma unroll
  for(int r=0;r<16;++r){const int d=d0+(r&3)+8*(r>>2); if(d>128||d<-128)p0[r]=NEG; if(d+32>128||d+32<-128)p1[r]=NEG;}
}

constexpr int NSLOT=3, SLOTB=8192;
constexpr int VSLOTB=16384;
constexpr int LDS_K=0, LDS_V=NSLOT*SLOTB, LDS_WS=LDS_V+NSLOT*VSLOTB, LDS_OST=LDS_WS+NW*64*4, LDS_BYTES=LDS_OST+NW*4096;
constexpr float C2=0.125f*1.4426950408889634f;
__device__ __forceinline__ void glds16(const void*gsrc,unsigned lds_dst){unsigned keep;
  asm volatile("s_mov_b32 %0, m0\n\ts_mov_b32 m0, %2\n\ts_nop 0\n\tglobal_load_lds_dwordx4 %1, off\n\ts_mov_b32 m0, %0":"=&s"(keep):"v"(gsrc),"s"(lds_dst):"memory");}
__device__ __forceinline__ float max3f(float a,float b,float c){float r;asm("v_max3_f32 %0, %1, %2, %3":"=v"(r):"v"(a),"v"(b),"v"(c));return r;}
__device__ __forceinline__ float max2f(float a,float b){float r;asm("v_max_f32_e32 %0, %1, %2":"=v"(r):"v"(a),"v"(b));return r;}
__device__ __forceinline__ float fadd_s(float a,float b){float r;asm("v_add_f32_e32 %0, %1, %2":"=v"(r):"v"(a),"v"(b));return r;}
__device__ __forceinline__ float fsub_s(float a,float b){float r;asm("v_sub_f32_e32 %0, %1, %2":"=v"(r):"v"(a),"v"(b));return r;}
typedef float f32x2_t __attribute__((ext_vector_type(2))); typedef __bf16 bf16x2_t __attribute__((ext_vector_type(2)));
__device__ __forceinline__ unsigned cvtpk_s(float lo,float hi){f32x2_t v={lo,hi};bf16x2_t b=__builtin_convertvector(v,bf16x2_t);return __builtin_bit_cast(unsigned,b);}
#define WAIT_BAR(N) asm volatile("s_waitcnt vmcnt(" #N ") lgkmcnt(0)\n\ts_barrier":::"memory")

__device__ __forceinline__ void qkt(f32x16&p0,f32x16&p1,const char*Kslot,const bf16x8*qr,const f32x16&negm,int r32,int hi){
  const char*kb=Kslot+hi*1024+r32*16;
  #pragma unroll
  for(int d0=0;d0<4;++d0){
    const bf16x8 b0=*reinterpret_cast<const bf16x8*>(kb+d0*2048);
    const bf16x8 b1=*reinterpret_cast<const bf16x8*>(kb+d0*2048+512);
    if(d0==0){p0=__builtin_amdgcn_mfma_f32_32x32x16_bf16(b0,qr[0],negm,0,0,0);p1=__builtin_amdgcn_mfma_f32_32x32x16_bf16(b1,qr[0],negm,0,0,0);}
    else{p0=__builtin_amdgcn_mfma_f32_32x32x16_bf16(b0,qr[d0],p0,0,0,0);p1=__builtin_amdgcn_mfma_f32_32x32x16_bf16(b1,qr[d0],p1,0,0,0);}}
}
typedef __attribute__((address_space(3))) const char* lds_cptr;
typedef short v4i16_t __attribute__((ext_vector_type(4)));
__device__ __forceinline__ void kload8(bf16x8*kf,lds_cptr kp){
  kf[0]=*(const __attribute__((address_space(3))) bf16x8*)(kp);      kf[1]=*(const __attribute__((address_space(3))) bf16x8*)(kp+512);
  kf[2]=*(const __attribute__((address_space(3))) bf16x8*)(kp+2048); kf[3]=*(const __attribute__((address_space(3))) bf16x8*)(kp+2560);
  kf[4]=*(const __attribute__((address_space(3))) bf16x8*)(kp+4096); kf[5]=*(const __attribute__((address_space(3))) bf16x8*)(kp+4608);
  kf[6]=*(const __attribute__((address_space(3))) bf16x8*)(kp+6144); kf[7]=*(const __attribute__((address_space(3))) bf16x8*)(kp+6656);
}
__device__ __forceinline__ void kload2(bf16x8*kf,lds_cptr kp,int j){ kf[2*j]=*(const __attribute__((address_space(3))) bf16x8*)(kp+j*2048); kf[2*j+1]=*(const __attribute__((address_space(3))) bf16x8*)(kp+j*2048+512); }
__device__ __forceinline__ s16x4 vtr(lds_cptr p){ return __builtin_bit_cast(s16x4,__builtin_amdgcn_ds_read_tr16_b64_v4i16((__attribute__((address_space(3))) v4i16_t*)p)); }
__device__ __forceinline__ float rowmax(const f32x16&p0,const f32x16&p1){
  float a=max3f(p0[0],p0[1],p1[0]),b=max3f(p0[2],p0[3],p1[1]);a=max3f(a,p1[2],p1[3]);
  #pragma unroll
  for(int r=4;r<16;r+=4){a=max3f(a,p0[r],p0[r+1]);b=max3f(b,p0[r+2],p0[r+3]);a=max3f(a,p1[r],p1[r+1]);b=max3f(b,p1[r+2],p1[r+3]);}
  const float m=max2f(a,b);
  auto rr=__builtin_amdgcn_permlane32_swap(__float_as_uint(m),__float_as_uint(m),false,false);
  return max2f(__uint_as_float(rr[0]),__uint_as_float(rr[1]));
}
template<int ND> __device__ __forceinline__ void pv(f32x16*o,int vb,bf16x8 pa0,bf16x8 pa1,bf16x8 pa2,bf16x8 pa3){
  #pragma unroll
  for(int d0=0;d0<ND;++d0){s16x4 lo[4],hi[4];
    #pragma unroll
    for(int ks=0;ks<4;++ks){
      asm volatile("ds_read_b64_tr_b16 %0,%1 offset:%c2":"=&v"(lo[ks]):"v"(vb),"i"(d0*4096+ks*1024):"memory");
      asm volatile("ds_read_b64_tr_b16 %0,%1 offset:%c2":"=&v"(hi[ks]):"v"(vb),"i"(d0*4096+ks*1024+512):"memory");}
    asm volatile("s_waitcnt lgkmcnt(0)":::"memory");SBAR();
    #define PK(k) (bf16x8){lo[k][0],lo[k][1],lo[k][2],lo[k][3],hi[k][0],hi[k][1],hi[k][2],hi[k][3]}
    o[d0]=__builtin_amdgcn_mfma_f32_32x32x16_bf16(pa0,PK(0),o[d0],0,0,0);
    o[d0]=__builtin_amdgcn_mfma_f32_32x32x16_bf16(pa1,PK(1),o[d0],0,0,0);
    o[d0]=__builtin_amdgcn_mfma_f32_32x32x16_bf16(pa2,PK(2),o[d0],0,0,0);
    o[d0]=__builtin_amdgcn_mfma_f32_32x32x16_bf16(pa3,PK(3),o[d0],0,0,0);
    #undef PK
  }
}

#ifndef ATTN_STORE16
#define ATTN_STORE16(p,v) (*(u32x4*)(p)=(v))
#endif
template<int THRL,bool WIN,int DM,int ODM,int DV,int QMODE> __device__ __forceinline__ void attn_unit(const bf16*Qp,const bf16*__restrict__ Kp,const bf16*__restrict__ Vp,bf16*Op,const int q0,const int t_lo,const int NT,const float sink2,char*shm,const float*qgain,const float*qtab,const int b0,const bool pre,const bf16*nKp,const bf16*nVp){
  int tid_=threadIdx.x; asm volatile("":"+v"(tid_));
  const int tid=tid_,lane=tid&63,r32=lane&31,hi=lane>>5; const int wid=__builtin_amdgcn_readfirstlane(tid>>6);
  const bf16*Qw=WIN?Qp+(long)((wid&1)*QBLK)*DM+(wid>>1)*64:Qp+(long)(wid*QBLK)*DM;
  const bf16*Kh=Kp+(long)t_lo*KVBLK*DM,*Vh=Vp+(long)t_lo*KVBLK*DM;
  const unsigned lds0=(unsigned)(uintptr_t)shm;
  float*wsf=(float*)(shm+LDS_WS)+wid*64;
  const bf16*ksrc=Kh+(long)lane*DM+wid*8;
  const bf16*vsrc=Vh+(long)(16*(wid&3)+(lane>>2))*DM+(wid>>2)*32+(lane&3)*8;
  const unsigned kdst=lds0+LDS_K+wid*1024, vdst=lds0+LDS_V+wid*1024;
  #define DMA_K(t,slot) glds16(ksrc+(long)(t)*KVBLK*DM,(unsigned)__builtin_amdgcn_readfirstlane(kdst+(slot)))
  constexpr int VM=DV/64;
  #define DMA_V(t,slot) do{ glds16(vsrc+(long)(t)*KVBLK*DM,(unsigned)__builtin_amdgcn_readfirstlane(vdst+VM*(slot))); \
    if constexpr(DV==128){ glds16(vsrc+64+(long)(t)*KVBLK*DM,(unsigned)__builtin_amdgcn_readfirstlane(vdst+VM*(slot)+8192)); } }while(0)
  #define WAIT_KV() do{ if constexpr(DV==128){WAIT_BAR(3);} else {WAIT_BAR(2);} }while(0)
  #define WAIT_V1() do{ if constexpr(DV==128){WAIT_BAR(2);} else {WAIT_BAR(1);} }while(0)
  const int vb0=(int)(lds0+LDS_V)+((lane>>4)&1)*32+(lane&3)*8+(4*hi+((lane&15)>>2))*64;
  const char*Kbase=shm+LDS_K; bf16x8 kf[8];
  const lds_cptr shm3=(lds_cptr)shm; const lds_cptr kp0=shm3+LDS_K+hi*1024+r32*16; const lds_cptr vp0=shm3+LDS_V+((lane>>4)&1)*32+(lane&3)*8+(4*hi+((lane&15)>>2))*64;
  const int s0=b0*SLOTB,s1=(s0==(NSLOT-1)*SLOTB)?0:s0+SLOTB,s2=(s1==(NSLOT-1)*SLOTB)?0:s1+SLOTB;
  if(!pre){DMA_K(0,s0);DMA_V(0,s0);DMA_K(1,s1);}
  bf16x8 qr[4];
  #pragma unroll
  for(int d0=0;d0<4;++d0)qr[d0]=*reinterpret_cast<const bf16x8*>(&Qw[(long)r32*DM+d0*16+hi*8]);
  float mhat=0.f,l_reg=0.f;f32x16 o[DV/32];
  #pragma unroll
  for(int d_=0;d_<DV/32;++d_)o[d_]=f32x16{};
  f32x16 negm=f32x16{};asm volatile("":"+v"(negm));
  const int qpos=WIN?q0+(wid&1)*QBLK+r32:q0+wid*QBLK+r32;
  #define CMASK(P0,P1,t) do{ if constexpr(WIN){ wmask(P0,P1,(t_lo+(t))*KVBLK+4*hi,qpos); } }while(0)
  bool resc=false;
  #define START(P0,P1) do{ const float rm=rowmax(P0,P1); resc=false; \
    { const float dl=WIN?__builtin_fmaxf(rm,-64.f):rm; mhat=fadd_s(mhat,dl); \
      _Pragma("unroll") for(int r=0;r<16;++r){P0[r]=fsub_s(P0[r],dl);P1[r]=fsub_s(P1[r],dl);} \
      _Pragma("unroll") for(int r=0;r<16;++r)negm[r]=-mhat; asm volatile("":"+v"(negm)); } \
    _Pragma("unroll") for(int r=0;r<16;++r)P0[r]=__builtin_amdgcn_exp2f(P0[r]); }while(0)
  #define RESC() do{ if(resc){ asm volatile("s_waitcnt lgkmcnt(0)":::"memory"); \
      _Pragma("unroll") for(int d_=0;d_<DV/32;++d_) _Pragma("unroll") for(int r=0;r<16;++r)o[d_][r]*=wsf[crow(r,hi)]; } }while(0)
  f32x16 pA0,pA1,pB0,pB1;
  int sl_prev=s0,sl_cur=s0,sl_next=s1;
  #define ROT() do{sl_prev=sl_cur;sl_cur=sl_next;sl_next=(sl_next==(NSLOT-1)*SLOTB)?0:sl_next+SLOTB;}while(0)
  if(!pre){DMA_K(2,s2);}
  if constexpr(QMODE!=0){
    typedef float f32x4_t __attribute__((ext_vector_type(4)));
    constexpr float QS=0.125f*1.4426950408889634f;
    float v[4][8];
    #pragma unroll
    for(int d0=0;d0<4;++d0){
      #pragma unroll
      for(int e=0;e<8;++e)v[d0][e]=__builtin_bit_cast(float,((unsigned)(unsigned short)qr[d0][e])<<16);}
    const int bp=(lane^32)<<2;
    if constexpr(QMODE==1){
      float ss=0.f;
      #pragma unroll
      for(int d0=0;d0<4;++d0){
        #pragma unroll
        for(int e=0;e<8;++e)ss+=v[d0][e]*v[d0][e];}
      ss+=__builtin_bit_cast(float,__builtin_amdgcn_ds_bpermute(bp,__builtin_bit_cast(int,ss)));
      const float rn=__builtin_amdgcn_rsqf(ss*(1.f/64.f)+1e-6f);
      const int trow=qpos>>6,tcol=qpos&63;
      #pragma unroll
      for(int d0=0;d0<4;++d0){ const f32x4_t g0=*(const f32x4_t*)(qgain+16*d0+8*hi),g1=*(const f32x4_t*)(qgain+16*d0+8*hi+4);
        const float g[8]={g0.x,g0.y,g0.z,g0.w,g1.x,g1.y,g1.z,g1.w};
        #pragma unroll
        for(int e=0;e<8;++e)v[d0][e]=(v[d0][e]*rn)*g[e];}
      #pragma unroll
      for(int h2=0;h2<2;++h2){ const float*tb=qtab+((h2==0?trow:tcol)*16+8*hi)*2;
        const f32x4_t c0=*(const f32x4_t*)(tb),c1=*(const f32x4_t*)(tb+4),c2=*(const f32x4_t*)(tb+8),c3=*(const f32x4_t*)(tb+12);
        const float cc[8]={c0.x,c0.z,c1.x,c1.z,c2.x,c2.z,c3.x,c3.z},sn[8]={c0.y,c0.w,c1.y,c1.w,c2.y,c2.w,c3.y,c3.w};
        #pragma unroll
        for(int e=0;e<8;++e){ const float x1=v[2*h2][e],x2=v[2*h2+1][e]; v[2*h2][e]=x1*cc[e]-x2*sn[e]; v[2*h2+1][e]=x2*cc[e]+x1*sn[e]; } }
    } else {
      const float*tb=qtab+(size_t)qpos*16;
      const f32x4_t c0=*(const f32x4_t*)(tb),c1=*(const f32x4_t*)(tb+4),c2=*(const f32x4_t*)(tb+8),c3=*(const f32x4_t*)(tb+12);
      const float cc[8]={c0.x,c0.z,c1.x,c1.z,c2.x,c2.z,c3.x,c3.z},sn[8]={c0.y,c0.w,c1.y,c1.w,c2.y,c2.w,c3.y,c3.w};
      const float sg=hi?1.f:-1.f;
      #pragma unroll
      for(int e=0;e<8;++e){ const float p=__builtin_bit_cast(float,__builtin_amdgcn_ds_bpermute(bp,__builtin_bit_cast(int,v[0][e]))); v[0][e]=v[0][e]*cc[e]+sg*(p*sn[e]); }
    }
    #pragma unroll
    for(int d0=0;d0<4;++d0){ u32x4 w; w[0]=cvtpk_s(v[d0][0]*QS,v[d0][1]*QS); w[1]=cvtpk_s(v[d0][2]*QS,v[d0][3]*QS); w[2]=cvtpk_s(v[d0][4]*QS,v[d0][5]*QS); w[3]=cvtpk_s(v[d0][6]*QS,v[d0][7]*QS);
      qr[d0]=__builtin_bit_cast(bf16x8,w); }
  }
  WAIT_BAR(3);
  qkt(pA0,pA1,Kbase+s0,qr,negm,r32,hi);asm volatile("s_nop 15\n\ts_nop 7":"+v"(pA0),"+v"(pA1));CMASK(pA0,pA1,0);
  START(pA0,pA1);
  _Pragma("unroll") for(int r=0;r<16;++r)pA1[r]=__builtin_amdgcn_exp2f(pA1[r]);
  WAIT_BAR(0);
  DMA_K(3,s0);DMA_V(1,s1);
  ROT();
  kload8(kf,kp0+sl_cur);
  WAIT_KV();
  s16x4 vlo[8],vhi[8]; u32x4 pw0,pw1,pw2,pw3;
  #define PKW(P,B) cvtpk_s(P[B],P[B+1])
  #define PAF(k) __builtin_bit_cast(bf16x8,pw##k)
  #define VFR(i) (bf16x8){vlo[i][0],vlo[i][1],vlo[i][2],vlo[i][3],vhi[i][0],vhi[i][1],vhi[i][2],vhi[i][3]}
  #define PIN(x) asm volatile("":"+v"(x))
  #define MX3(a,b,c) __builtin_fmaxf(__builtin_fmaxf((a),(b)),(c))
  #define GAPA(MF,A0,A1,A2,A3,W0,W1,PW) do{ MF; sacc+=A0; sacc+=A1; sacc+=A2; sacc+=A3; PIN(sacc); W0; W1; PIN(PW); SBAR(); }while(0)
  #define EX(v) __builtin_amdgcn_exp2f(v)
  #define GAPB(MF,X,B) do{ MF; X[B]=EX(X[B]); X[B+1]=EX(X[B+1]); X[B+2]=EX(X[B+2]); X[B+3]=EX(X[B+3]); PIN(X); SBAR(); }while(0)
  #define VRD(i) do{ vlo[i]=vtr(vp_+(((i)>>2)*4096+((i)&3)*1024)); vhi[i]=vtr(vp_+(((i)>>2)*4096+((i)&3)*1024+512)); }while(0)
  #define KRD(G,j) do{ if(G){ kload2(kf,kp0+sl_next,j); SBAR(); } }while(0)
  #define VRD2(i) do{ if constexpr(DV==128){ vlo[i]=vtr(vp_+((((i)>>2)+2)*4096+((i)&3)*1024)); vhi[i]=vtr(vp_+((((i)>>2)+2)*4096+((i)&3)*1024+512)); SBAR(); } }while(0)
  #define GAPC(MF) do{ MF; SBAR(); }while(0)
  #define GAPB2(MF,X,B) do{ MF; X[B]=EX(X[B]); X[B+1]=EX(X[B+1]); PIN(X); SBAR(); }while(0)
  #define STEP(C0,C1,P0,P1,t,GK,GV,GL) do{ SBAR(); \
    const lds_cptr vp_=vp0+VM*sl_prev; \
    VRD(0); SBAR(); float sacc=(P0[0]+P0[1]); \
    GAPA(C0=__builtin_amdgcn_mfma_f32_32x32x16_bf16(kf[0],qr[0],negm,0,0,0), P0[2],P0[3],P0[4],P0[5],     pw0[0]=PKW(P0,0), pw0[1]=PKW(P0,2), pw0); \
    VRD(4); SBAR(); GAPA(C1=__builtin_amdgcn_mfma_f32_32x32x16_bf16(kf[1],qr[0],negm,0,0,0), P0[6],P0[7],P0[8],P0[9],     pw0[2]=PKW(P0,4), pw0[3]=PKW(P0,6), pw0); \
    VRD(1); SBAR(); GAPA(C0=__builtin_amdgcn_mfma_f32_32x32x16_bf16(kf[2],qr[1],C0,0,0,0),   P0[10],P0[11],P0[12],P0[13], pw1[0]=PKW(P0,8), pw1[1]=PKW(P0,10), pw1); \
    VRD(5); SBAR(); GAPA(C1=__builtin_amdgcn_mfma_f32_32x32x16_bf16(kf[3],qr[1],C1,0,0,0),   P0[14],P0[15],P1[0],P1[1],   pw1[2]=PKW(P0,12),pw1[3]=PKW(P0,14), pw1); \
    VRD(2); SBAR(); GAPA(C0=__builtin_amdgcn_mfma_f32_32x32x16_bf16(kf[4],qr[2],C0,0,0,0),   P1[2],P1[3],P1[4],P1[5],     pw2[0]=PKW(P1,0), pw2[1]=PKW(P1,2), pw2); \
    VRD(6); SBAR(); GAPA(C1=__builtin_amdgcn_mfma_f32_32x32x16_bf16(kf[5],qr[2],C1,0,0,0),   P1[6],P1[7],P1[8],P1[9],     pw2[2]=PKW(P1,4), pw2[3]=PKW(P1,6), pw2); \
    VRD(3); SBAR(); GAPA(C0=__builtin_amdgcn_mfma_f32_32x32x16_bf16(kf[6],qr[3],C0,0,0,0),   P1[10],P1[11],P1[12],P1[13], pw3[0]=PKW(P1,8), pw3[1]=PKW(P1,10), pw3); \
    VRD(7); SBAR(); GAPA(C1=__builtin_amdgcn_mfma_f32_32x32x16_bf16(kf[7],qr[3],C1,0,0,0),   P1[14],P1[15],0.f,0.f,       pw3[2]=PKW(P1,12),pw3[3]=PKW(P1,14), pw3); \
    l_reg+=sacc; \
    if(GK){DMA_K((t)+3,sl_cur);} if(GV){DMA_V((t)+1,sl_next);} \
    CMASK(C0,C1,t); \
    { float a=MX3(C0[0],C0[1],C1[0]),b=MX3(C0[2],C0[3],C1[1]); a=MX3(a,C1[2],C1[3]); \
      _Pragma("unroll") for(int r=4;r<16;r+=4){a=MX3(a,C0[r],C0[r+1]);b=MX3(b,C0[r+2],C0[r+3]);a=MX3(a,C1[r],C1[r+1]);b=MX3(b,C1[r+2],C1[r+3]);} \
      float rm=__builtin_fmaxf(a,b); { auto rr=__builtin_amdgcn_permlane32_swap(__float_as_uint(rm),__float_as_uint(rm),false,false); rm=__builtin_fmaxf(__uint_as_float(rr[0]),__uint_as_float(rr[1])); } \
      resc=false; \
      if(__builtin_expect(__any(rm>(float)THRL),0)){ const float dl=__builtin_fmaxf(rm,0.f); mhat+=dl; \
        _Pragma("unroll") for(int r=0;r<16;++r){C0[r]-=dl;C1[r]-=dl;} \
        _Pragma("unroll") for(int r=0;r<16;++r)negm[r]=-mhat; asm volatile("":"+v"(negm)); \
        const float f=__builtin_amdgcn_exp2f(-dl); l_reg*=f; if(hi==0)wsf[r32]=f; resc=true; } } \
    SBAR(); \
    if constexpr(DV==64){ \
    GAPB(o[0]=__builtin_amdgcn_mfma_f32_32x32x16_bf16(PAF(0),VFR(0),o[0],0,0,0), C0,0); \
    GAPB(o[1]=__builtin_amdgcn_mfma_f32_32x32x16_bf16(PAF(0),VFR(4),o[1],0,0,0), C0,4); \
    KRD(GL,0); GAPB(o[0]=__builtin_amdgcn_mfma_f32_32x32x16_bf16(PAF(1),VFR(1),o[0],0,0,0), C0,8); \
    KRD(GL,1); GAPB(o[1]=__builtin_amdgcn_mfma_f32_32x32x16_bf16(PAF(1),VFR(5),o[1],0,0,0), C0,12); \
    KRD(GL,2); GAPB(o[0]=__builtin_amdgcn_mfma_f32_32x32x16_bf16(PAF(2),VFR(2),o[0],0,0,0), C1,0); \
    KRD(GL,3); GAPB(o[1]=__builtin_amdgcn_mfma_f32_32x32x16_bf16(PAF(2),VFR(6),o[1],0,0,0), C1,4); \
    GAPB(o[0]=__builtin_amdgcn_mfma_f32_32x32x16_bf16(PAF(3),VFR(3),o[0],0,0,0), C1,8); \
    GAPB(o[1]=__builtin_amdgcn_mfma_f32_32x32x16_bf16(PAF(3),VFR(7),o[1],0,0,0), C1,12); \
    } else {   \
    GAPB2(o[0]=__builtin_amdgcn_mfma_f32_32x32x16_bf16(PAF(0),VFR(0),o[0],0,0,0), C0,0);  VRD2(0); \
    GAPB2(o[1]=__builtin_amdgcn_mfma_f32_32x32x16_bf16(PAF(0),VFR(4),o[1],0,0,0), C0,2);  VRD2(4); \
    GAPB2(o[0]=__builtin_amdgcn_mfma_f32_32x32x16_bf16(PAF(1),VFR(1),o[0],0,0,0), C0,4);  VRD2(1); \
    GAPB2(o[1]=__builtin_amdgcn_mfma_f32_32x32x16_bf16(PAF(1),VFR(5),o[1],0,0,0), C0,6);  VRD2(5); \
    GAPB2(o[0]=__builtin_amdgcn_mfma_f32_32x32x16_bf16(PAF(2),VFR(2),o[0],0,0,0), C0,8);  VRD2(2); \
    GAPB2(o[1]=__builtin_amdgcn_mfma_f32_32x32x16_bf16(PAF(2),VFR(6),o[1],0,0,0), C0,10); VRD2(6); \
    GAPB2(o[0]=__builtin_amdgcn_mfma_f32_32x32x16_bf16(PAF(3),VFR(3),o[0],0,0,0), C0,12); VRD2(3); \
    GAPB2(o[1]=__builtin_amdgcn_mfma_f32_32x32x16_bf16(PAF(3),VFR(7),o[1],0,0,0), C0,14); VRD2(7); \
    GAPB2(o[DV/32-2]=__builtin_amdgcn_mfma_f32_32x32x16_bf16(PAF(0),VFR(0),o[DV/32-2],0,0,0), C1,0); \
    GAPB2(o[DV/32-1]=__builtin_amdgcn_mfma_f32_32x32x16_bf16(PAF(0),VFR(4),o[DV/32-1],0,0,0), C1,2); \
    KRD(GL,0); GAPB2(o[DV/32-2]=__builtin_amdgcn_mfma_f32_32x32x16_bf16(PAF(1),VFR(1),o[DV/32-2],0,0,0), C1,4); \
    KRD(GL,1); GAPB2(o[DV/32-1]=__builtin_amdgcn_mfma_f32_32x32x16_bf16(PAF(1),VFR(5),o[DV/32-1],0,0,0), C1,6); \
    KRD(GL,2); GAPB2(o[DV/32-2]=__builtin_amdgcn_mfma_f32_32x32x16_bf16(PAF(2),VFR(2),o[DV/32-2],0,0,0), C1,8); \
    KRD(GL,3); GAPB2(o[DV/32-1]=__builtin_amdgcn_mfma_f32_32x32x16_bf16(PAF(2),VFR(6),o[DV/32-1],0,0,0), C1,10); \
    GAPB2(o[DV/32-2]=__builtin_amdgcn_mfma_f32_32x32x16_bf16(PAF(3),VFR(3),o[DV/32-2],0,0,0), C1,12); \
    GAPB2(o[DV/32-1]=__builtin_amdgcn_mfma_f32_32x32x16_bf16(PAF(3),VFR(7),o[DV/32-1],0,0,0), C1,14); \
    } \
    }while(0)
  int t=1;
  for(;t+5<NT;t+=2){
    STEP(pB0,pB1,pA0,pA1,t,true,true,true);     WAIT_KV(); RESC(); ROT();
    STEP(pA0,pA1,pB0,pB1,t+1,true,true,true);   WAIT_KV(); RESC(); ROT();
  }
  #define ENDW(tt) do{ if((tt)+3<NT){WAIT_KV();} else if((tt)+2<NT){WAIT_V1();} else {WAIT_BAR(0);} }while(0)
  for(;t+1<NT;t+=2){
    STEP(pB0,pB1,pA0,pA1,t,(t+3<NT),(t+1<NT),(t+1<NT));       ENDW(t);   RESC(); ROT();
    STEP(pA0,pA1,pB0,pB1,t+1,(t+4<NT),(t+2<NT),(t+2<NT));     ENDW(t+1); RESC(); ROT();
  }
  STEP(pB0,pB1,pA0,pA1,NT-1,false,false,false); RESC();
  { float sacc=pB0[0]+pB0[1]; _Pragma("unroll") for(int r=2;r<16;++r)sacc+=pB0[r]; _Pragma("unroll") for(int r=0;r<16;++r)sacc+=pB1[r]; l_reg+=sacc;
    pw0=(u32x4){PKW(pB0,0),PKW(pB0,2),PKW(pB0,4),PKW(pB0,6)};pw1=(u32x4){PKW(pB0,8),PKW(pB0,10),PKW(pB0,12),PKW(pB0,14)};pw2=(u32x4){PKW(pB1,0),PKW(pB1,2),PKW(pB1,4),PKW(pB1,6)};pw3=(u32x4){PKW(pB1,8),PKW(pB1,10),PKW(pB1,12),PKW(pB1,14)};
    SBAR(); pv<DV/32>(o,vb0+VM*sl_cur,PAF(0),PAF(1),PAF(2),PAF(3)); }
  if(nKp){
    const int n0=(sl_cur==(NSLOT-1)*SLOTB)?0:sl_cur+SLOTB,n1=(n0==(NSLOT-1)*SLOTB)?0:n0+SLOTB,n2=(n1==(NSLOT-1)*SLOTB)?0:n1+SLOTB;
    const bf16*nks=nKp+(long)lane*DM+wid*8; const bf16*nvs=nVp+(long)(16*(wid&3)+(lane>>2))*DM+(wid>>2)*32+(lane&3)*8;
    glds16(nks,(unsigned)__builtin_amdgcn_readfirstlane(kdst+n0));
    glds16(nvs,(unsigned)__builtin_amdgcn_readfirstlane(vdst+VM*n0)); if constexpr(DV==128){ glds16(nvs+64,(unsigned)__builtin_amdgcn_readfirstlane(vdst+VM*n0+8192)); }
    glds16(nks+(long)KVBLK*DM,(unsigned)__builtin_amdgcn_readfirstlane(kdst+n1));
    glds16(nks+(long)2*KVBLK*DM,(unsigned)__builtin_amdgcn_readfirstlane(kdst+n2)); }
  #undef PKW
  #undef PAF
  #undef VFR
  #undef PIN
  #undef MX3
  #undef GAPA
  #undef GAPB
  #undef EX
  #undef VRD
  #undef KRD
  #undef STEP
  #undef ENDW
  {auto rr=__builtin_amdgcn_permlane32_swap(__float_as_uint(l_reg),__float_as_uint(l_reg),false,false);l_reg=__uint_as_float(rr[0])+__uint_as_float(rr[1]);}
  if constexpr(WIN){ l_reg+=__builtin_amdgcn_exp2f(qgain[wid>>1]*1.4426950408889634f-mhat); }
  if(hi==0)wsf[32+r32]=l_reg;asm volatile("s_waitcnt lgkmcnt(0)":::"memory");
  float rli[16];
  #pragma unroll
  for(int r=0;r<16;++r)rli[r]=__builtin_amdgcn_rcpf(wsf[32+crow(r,hi)]);
  bf16*Ow=WIN?Op+(long)((wid&1)*QBLK)*ODM+(wid>>1)*64:Op+(long)(wid*QBLK)*ODM;
  #pragma unroll
  for(int hf=0;hf<DV/64;++hf){ bf16*stg=(bf16*)(shm+LDS_OST)+wid*2048;
    #pragma unroll
    for(int r=0;r<16;++r){const int orow=crow(r,hi);
      #pragma unroll
      for(int d0=0;d0<2;++d0)stg[orow*64+d0*32+r32]=__float2bfloat16(o[2*hf+d0][r]*rli[r]);}
    asm volatile("s_waitcnt lgkmcnt(0)":::"memory");
    #pragma unroll
    for(int i=0;i<4;++i){const int row=i*8+(lane>>3),ch=lane&7; const u32x4 v=*(const u32x4*)(stg+row*64+ch*8); ATTN_STORE16(Ow+(long)row*ODM+hf*64+ch*8,v);}
    asm volatile("s_waitcnt lgkmcnt(0)":::"memory"); }
  asm volatile("s_waitcnt lgkmcnt(0)\n\ts_barrier":::"memory");
  #undef DMA_K
  #undef DMA_V
  #undef WAIT_KV
  #undef WAIT_V1
  #undef VRD2
  #undef GAPC
  #undef GAPB2
  #undef CMASK
  #undef START
  #undef RESC
  #undef ROT
}
constexpr int ATTN_LDS_BYTES=LDS_BYTES;
#undef SBAR
#undef WAIT_BAR
}
#include <hip/hip_cooperative_groups.h>
namespace cg = cooperative_groups;
constexpr int NWAVES = 8;
constexpr int DMODEL = 1024, MP = 65536, MS_ = 16384, MTOK = MP + MS_;
constexpr int EVEN_IN = 2304, ODD_IN = 1536, FFH = 2816, GU = 2 * FFH;
constexpr float EPSN = 1e-6f;
constexpr float QSCALE = 0.125f * 1.4426950408889634f;
constexpr size_t MiB = 1u << 20;
constexpr size_t WS_ROPE = 0, WS_AX = 512 * 1024, WS_BAR = 576 * 1024, WS_RS = 640 * 1024;
constexpr size_t WS_WINE = 1 * MiB, WS_WOUTE = 10 * MiB, WS_WINO = 14 * MiB, WS_WOUTO = 20 * MiB, WS_WGU = 24 * MiB, WS_WDN = 68 * MiB;
constexpr size_t WS_H = 90 * MiB;
constexpr size_t WS_OB = 250 * MiB;
constexpr size_t WS_QKV = 410 * MiB;
constexpr size_t WS_ATT = 90 * MiB;
constexpr size_t WS_XB = 850 * MiB;
constexpr size_t WS_HID = 410 * MiB;
constexpr size_t WS_END = 1010 * MiB;
constexpr int LDS_BYTES = 147456;

#define GAS __attribute__((address_space(1)))
#define LAS __attribute__((address_space(3)))
typedef unsigned short bf16;
typedef unsigned v4u __attribute__((ext_vector_type(4)));
typedef unsigned v2u __attribute__((ext_vector_type(2)));
typedef float f32x4 __attribute__((ext_vector_type(4)));
typedef float f32x2 __attribute__((ext_vector_type(2)));
#define LDS_WAIT() asm volatile("s_waitcnt lgkmcnt(0)" ::: "memory")
__device__ __forceinline__ unsigned f2bf(float f) { unsigned u = __builtin_bit_cast(unsigned, f); return (u + 0x7fffu + ((u >> 16) & 1u)) >> 16; }
__device__ __forceinline__ unsigned pk2(float lo, float hi) { return f2bf(lo) | (f2bf(hi) << 16); }
__device__ __forceinline__ float bflo(unsigned w) { return __builtin_bit_cast(float, w << 16); }
__device__ __forceinline__ float bfhi(unsigned w) { return __builtin_bit_cast(float, w & 0xffff0000u); }
template <int CTRL> __device__ __forceinline__ float dppf(float v) { return __builtin_bit_cast(float, __builtin_amdgcn_update_dpp(0, __builtin_bit_cast(int, v), CTRL, 0xf, 0xf, false)); }
#define DPP_XOR1 0xB1
#define DPP_XOR2 0x4E
#define DPP_HMIR 0x141
#define DPP_MIR  0x140
__device__ __forceinline__ float sum8(float v) { v += dppf<DPP_XOR1>(v); v += dppf<DPP_XOR2>(v); v += dppf<DPP_HMIR>(v); return v; }
__device__ __forceinline__ float sum16(float v) { v = sum8(v); v += dppf<DPP_MIR>(v); return v; }
__device__ __forceinline__ float bperm_xor(float v, int lane, int m) { return __builtin_bit_cast(float, __builtin_amdgcn_ds_bpermute((lane ^ m) << 2, __builtin_bit_cast(int, v))); }
__device__ __forceinline__ float wave_sum(float v, int lane) { v = sum16(v); v += bperm_xor(v, lane, 16); v += bperm_xor(v, lane, 32); return v; }
__constant__ float ROPE_INV[8] = {1.f, 0.193922743f, 0.0376060307f, 0.00729266461f, 0.00141421356f, 0.000274248188f, 5.31829573e-05f, 1.03133852e-05f};
__constant__ float AX_INV[16] = {1.f, 0.562341332f, 0.316227764f, 0.177827939f, 0.100000001f, 0.0562341325f, 0.0316227749f, 0.0177827943f, 0.00999999978f, 0.00562341325f,
                                 0.00316227763f, 0.00177827943f, 0.00100000005f, 0.000562341302f, 0.000316227757f, 0.00017782794f};


__device__ __forceinline__ void transpose_item(const float* W, int K, int N, bf16* WT, int swiglu, LAS float* scr, int item, int lane, const float* kgain) {
    const int nblk = N / 32, kb = item / nblk, nb = item % nblk, k0 = 64 * kb, n0 = 32 * nb;
    int drow0 = n0;
    if (swiglu) { const int s = n0 / FFH, j0 = n0 % FFH; drow0 = 256 * (j0 / 128) + 128 * s + (j0 % 128); }
#pragma unroll 8
    for (int i = 0; i < 32; ++i) { const int kk = 2 * i + (lane >> 5); scr[kk * 33 + (lane & 31)] = W[(size_t)(k0 + kk) * N + n0 + (lane & 31)] * (kgain ? kgain[k0 + kk] : 1.f); }
    LDS_WAIT(); asm volatile("" ::: "memory");
    const int c = lane & 7;
#pragma unroll
    for (int j = 0; j < 4; ++j) { const int n = (lane >> 3) + 8 * j; const LAS float* s = scr + (8 * c) * 33 + n;
        v4u o; o.x = pk2(s[0 * 33], s[1 * 33]); o.y = pk2(s[2 * 33], s[3 * 33]); o.z = pk2(s[4 * 33], s[5 * 33]); o.w = pk2(s[6 * 33], s[7 * 33]);
        *(GAS v4u*)(WT + (size_t)(drow0 + n) * K + k0 + 8 * c) = o; }
    LDS_WAIT(); asm volatile("" ::: "memory");
}

__device__ __forceinline__ f32x2 cossin(float ang) {
    const double a = (double)ang; const double k = __builtin_rint(a * 0.63661977236758134308); const double r = a - k * 1.57079632679489661923;
    const double r2 = r * r;
    const double sn = r * (1.0 + r2 * (-1.0 / 6 + r2 * (1.0 / 120 + r2 * (-1.0 / 5040 + r2 * (1.0 / 362880 + r2 * (-1.0 / 39916800 + r2 * (1.0 / 6227020800.0)))))));
    const double cs = 1.0 + r2 * (-0.5 + r2 * (1.0 / 24 + r2 * (-1.0 / 720 + r2 * (1.0 / 40320 + r2 * (-1.0 / 3628800 + r2 * (1.0 / 479001600.0))))));
    const int q = ((int)k) & 3;
    const double c = (q == 0) ? cs : (q == 1) ? -sn : (q == 2) ? -cs : sn;
    const double s = (q == 0) ? sn : (q == 1) ? cs : (q == 2) ? -sn : -cs;
    return (f32x2){(float)c, (float)s};
}

#define XB_TMO      128
#define XB_XCNT(j)  (256  + 64 * (j))
#define XB_XSUB(j)  (1280 + 64 * (j))
#define XB_XGEN(j)  (2304 + 64 * (j))
#define XB_TOP      3328
#define XB_TOPGEN   3392
#define XCD_BAR_WORDS 3456
#define XB_SPIN_CAP (1u << 18)

__device__ __forceinline__ unsigned xb_ld(unsigned* p)              { return __hip_atomic_load(p, __ATOMIC_RELAXED, __HIP_MEMORY_SCOPE_AGENT); }
__device__ __forceinline__ unsigned xb_add(unsigned* p, unsigned v) { return __hip_atomic_fetch_add(p, v, __ATOMIC_RELAXED, __HIP_MEMORY_SCOPE_AGENT); }
__device__ __forceinline__ unsigned xb_xcc_id() { return (unsigned)__builtin_amdgcn_s_getreg((3 << 11) | 20) & 0xFu; }
#define XB_SPIN(cond, bar) do { unsigned _sp = 0; while (cond) { __builtin_amdgcn_s_sleep(1); \
    if ((++_sp & 255u) == 0u) { if (xb_ld(&(bar)[XB_TMO])) break; if (_sp > XB_SPIN_CAP) { atomicAdd(&(bar)[XB_TMO], 1u); break; } } } } while (0)

struct XcdBarrier {
    unsigned* bar; unsigned x;
    volatile LAS unsigned* st;
};

__device__ __forceinline__ XcdBarrier xcd_barrier_post(unsigned* bar, volatile LAS unsigned* st) {
    XcdBarrier b; b.bar = bar; b.x = xb_xcc_id(); b.st = st;
    if (threadIdx.x == 0) (void)xb_add(&bar[XB_XCNT(b.x)], 1u);
    return b;
}
__device__ __forceinline__ void xcd_barrier_complete(unsigned* bar, unsigned x, unsigned& nloc, unsigned& nx) {
    const unsigned G = gridDim.x * gridDim.y * gridDim.z;
    unsigned sum, cnt, mine, sp = 0u;
    for (;;) {
        sum = 0u; cnt = 0u; mine = 0u;
#pragma unroll
        for (unsigned j = 0; j < 16; ++j) { const unsigned c = xb_ld(&bar[XB_XCNT(j)]); sum += c; cnt += (c > 0u) ? 1u : 0u; mine = (j == x) ? c : mine; }
        if (sum == G) break;
        __builtin_amdgcn_s_sleep(1);
        if ((++sp & 255u) == 0u) { if (xb_ld(&bar[XB_TMO])) break; if (sp > XB_SPIN_CAP) { atomicAdd(&bar[XB_TMO], 1u); break; } }
    }
    nloc = mine > 0u ? mine : 1u; nx = cnt > 0u ? cnt : 1u;
}

__device__ __forceinline__ void xcd_barrier(const XcdBarrier& b) {
    asm volatile("s_waitcnt vmcnt(0)" ::: "memory");
    __syncthreads();
    if (threadIdx.x == 0) {
        unsigned* bar = b.bar;
        __builtin_amdgcn_s_waitcnt(0);
        unsigned nloc = b.st[0], nx = b.st[1];
        if (nloc == 0u) { xcd_barrier_complete(bar, b.x, nloc, nx); b.st[0] = nloc; b.st[1] = nx; }
        const unsigned old = xb_add(&bar[XB_XSUB(b.x)], 1u);
        const unsigned gen = old / nloc;
        if (old + 1u == (gen + 1u) * nloc) {
            __builtin_amdgcn_fence(__ATOMIC_RELEASE, "agent");
            asm volatile("s_waitcnt vmcnt(0)" ::: "memory");
            const unsigned og = xb_add(&bar[XB_TOP], 1u);
            const unsigned tg = og / nx;
            if (og + 1u == (tg + 1u) * nx) xb_add(&bar[XB_TOPGEN], 1u);
            else XB_SPIN(xb_ld(&bar[XB_TOPGEN]) == tg, bar);
            __builtin_amdgcn_fence(__ATOMIC_ACQUIRE, "agent");
            xb_add(&bar[XB_XGEN(b.x)], 1u);
            asm volatile("s_waitcnt vmcnt(0)" ::: "memory");
        } else {
            XB_SPIN(xb_ld(&bar[XB_XGEN(b.x)]) == gen, bar);
            __builtin_amdgcn_fence(__ATOMIC_ACQUIRE, "agent");
            asm volatile("s_waitcnt vmcnt(0)" ::: "memory");
        }
    }
    __syncthreads();
}

__device__ __forceinline__ void rownorm_row(int lane, const float* xsrc, const bf16* mrow, const float* gpost, bf16* xdst, bf16* hrow, const float* gpre) {
    f32x4 v[4];
#pragma unroll
    for (int j = 0; j < 4; ++j) v[j] = *(const f32x4*)(xsrc + 4 * lane + 256 * j);
    if (mrow) {
        f32x4 mm[4]; float ss = 0.f;
#pragma unroll
        for (int j = 0; j < 4; ++j) { const v2u w = *(const v2u*)(mrow + 4 * lane + 256 * j); mm[j] = (f32x4){bflo(w.x), bfhi(w.x), bflo(w.y), bfhi(w.y)};
            ss += (mm[j].x * mm[j].x + mm[j].y * mm[j].y) + (mm[j].z * mm[j].z + mm[j].w * mm[j].w); }
        const float r = __builtin_amdgcn_rsqf(wave_sum(ss, lane) * (1.f / DMODEL) + EPSN);
#pragma unroll
        for (int j = 0; j < 4; ++j) { const f32x4 g = *(const f32x4*)(gpost + 4 * lane + 256 * j); v[j] = v[j] + (mm[j] * r) * g; }
    }
#pragma unroll
    for (int j = 0; j < 4; ++j) { v2u w; w.x = pk2(v[j].x, v[j].y); w.y = pk2(v[j].z, v[j].w); *(v2u*)(xdst + 4 * lane + 256 * j) = w; }
    if (gpre) {
        float ss = 0.f;
#pragma unroll
        for (int j = 0; j < 4; ++j) ss += (v[j].x * v[j].x + v[j].y * v[j].y) + (v[j].z * v[j].z + v[j].w * v[j].w);
        const float r = __builtin_amdgcn_rsqf(wave_sum(ss, lane) * (1.f / DMODEL) + EPSN);
#pragma unroll
        for (int j = 0; j < 4; ++j) { const f32x4 g = *(const f32x4*)(gpre + 4 * lane + 256 * j); const f32x4 o = (v[j] * r) * g;
            v2u w; w.x = pk2(o.x, o.y); w.y = pk2(o.z, o.w); *(v2u*)(hrow + 4 * lane + 256 * j) = w; }
    }
}

__device__ __forceinline__ void rownorm_pass(int lane, int gw, int NGW, bf16* XB, const bf16* MB, const float* gpost, float* RS, float* OUT) {
    f32x4 gp[4];
#pragma unroll
    for (int j = 0; j < 4; ++j) gp[j] = *(const f32x4*)(gpost + 4 * lane + 256 * j);
    v2u nx[4], nm[4];
    int row = gw;
    if (row < MTOK) {
#pragma unroll
        for (int j = 0; j < 4; ++j) { nx[j] = *(const v2u*)(XB + (size_t)row * DMODEL + 4 * lane + 256 * j); nm[j] = __builtin_nontemporal_load((const v2u*)(MB + (size_t)row * DMODEL + 4 * lane + 256 * j)); }
    }
    while (row < MTOK) {
        v2u xw[4], w[4];
#pragma unroll
        for (int j = 0; j < 4; ++j) { xw[j] = nx[j]; w[j] = nm[j]; }
        const int nrow = row + NGW;
        if (nrow < MTOK) {
#pragma unroll
            for (int j = 0; j < 4; ++j) { nx[j] = *(const v2u*)(XB + (size_t)nrow * DMODEL + 4 * lane + 256 * j); nm[j] = __builtin_nontemporal_load((const v2u*)(MB + (size_t)nrow * DMODEL + 4 * lane + 256 * j)); }
        }
        f32x4 v[4], mm[4]; float ss = 0.f;
#pragma unroll
        for (int j = 0; j < 4; ++j) { mm[j] = (f32x4){bflo(w[j].x), bfhi(w[j].x), bflo(w[j].y), bfhi(w[j].y)}; v[j] = (f32x4){bflo(xw[j].x), bfhi(xw[j].x), bflo(xw[j].y), bfhi(xw[j].y)};
            ss += (mm[j].x * mm[j].x + mm[j].y * mm[j].y) + (mm[j].z * mm[j].z + mm[j].w * mm[j].w); }
        const float r = __builtin_amdgcn_rsqf(wave_sum(ss, lane) * (1.f / DMODEL) + EPSN);
        float s2 = 0.f;
#pragma unroll
        for (int j = 0; j < 4; ++j) { v[j] = v[j] + (mm[j] * r) * gp[j]; s2 += (v[j].x * v[j].x + v[j].y * v[j].y) + (v[j].z * v[j].z + v[j].w * v[j].w); }
        if (OUT) {
#pragma unroll
            for (int j = 0; j < 4; ++j) *(f32x4*)(OUT + (size_t)row * DMODEL + 4 * lane + 256 * j) = v[j];
        } else {
#pragma unroll
            for (int j = 0; j < 4; ++j) { v2u q; q.x = pk2(v[j].x, v[j].y); q.y = pk2(v[j].z, v[j].w); *(v2u*)(XB + (size_t)row * DMODEL + 4 * lane + 256 * j) = q; }
        }
        if (RS) { const float r2 = __builtin_amdgcn_rsqf(wave_sum(s2, lane) * (1.f / DMODEL) + EPSN); if (lane == 0) RS[row] = r2; }
        row = nrow;
    }
}

struct Args { const float* in[15]; float* out; unsigned char* ws; };
template <int OFF> __device__ __forceinline__ __attribute__((address_space(1))) void* karg() { __attribute__((address_space(1))) void* p; asm volatile("s_load_dwordx2 %0, %1, %2\n\ts_waitcnt lgkmcnt(0)" : "=s"(p) : "s"(__builtin_amdgcn_kernarg_segment_ptr()), "n"(OFF)); return p; }
#define ARG_IN(i) ((const float*)karg<8 * (i)>())
#define ARG_OUT() ((float*)karg<120>())
#define ARG_WS() ((unsigned char*)karg<128>())
#define P_X() float* const X = ARG_OUT()
#define P_WS(name, off) bf16* const name = (bf16*)(ARG_WS() + (off))

__device__ __forceinline__ v4u prep_compute(const v4u rw, const f32x4 (&tb)[4], int type, int sub, const float* qkg) {
    const bool isA = type < 2;
    const float cc[8] = {tb[0].x, tb[0].z, tb[1].x, tb[1].z, tb[2].x, tb[2].z, tb[3].x, tb[3].z};
    const float sn[8] = {tb[0].y, tb[0].w, tb[1].y, tb[1].w, tb[2].y, tb[2].w, tb[3].y, tb[3].w};
    float v[8] = {bflo(rw.x), bfhi(rw.x), bflo(rw.y), bfhi(rw.y), bflo(rw.z), bfhi(rw.z), bflo(rw.w), bfhi(rw.w)};
    float ss = 0.f;
#pragma unroll
    for (int i = 0; i < 8; ++i) ss += v[i] * v[i];
    ss = sum8(ss);
    const float rn = isA ? __builtin_amdgcn_rsqf(ss * (1.f / 64.f) + EPSN) : 1.f;
    const float* gp = qkg + (type & 1) * 64 + 8 * sub;
#pragma unroll
    for (int i = 0; i < 8; ++i) v[i] = isA ? (v[i] * rn) * gp[i] : v[i];
    const bool active = isA || sub < 2;
    const float sg = (isA ? (sub & 2) : (sub & 1)) ? 1.f : -1.f;
#pragma unroll
    for (int i = 0; i < 8; ++i) {
        const float p1 = dppf<DPP_XOR1>(v[i]), p2 = dppf<DPP_XOR2>(v[i]);
        const float pr = isA ? p2 : p1;
        const float rv = v[i] * cc[i] + sg * (pr * sn[i]);
        v[i] = active ? rv : v[i];
    }
    v4u o; o.x = pk2(v[0], v[1]); o.y = pk2(v[2], v[3]); o.z = pk2(v[4], v[5]); o.w = pk2(v[6], v[7]);
    return o;
}
struct PrepOrder : pg8::StaticOrder {
    int even, l2;
    __device__ __forceinline__ void done(const pg8::Unit& u) const {
        const int colt = u.pn * 256;
        if (even ? !(colt == 512 || colt == 1280 || colt == 1536) : (colt != 1024)) return;
        asm volatile("s_waitcnt vmcnt(0)" ::: "memory");
        __builtin_amdgcn_s_barrier();
        asm volatile("" ::: "memory");
        int tid_ = threadIdx.x; asm volatile("" : "+v"(tid_));
        const int sub = tid_ & 7, gidx = tid_ >> 3;
        unsigned char* const ws = ARG_WS(); bf16* const QKV = (bf16*)(ws + WS_QKV); const f32x2* const ropeT = (const f32x2*)(ws + WS_ROPE); const f32x2* const axT = (const f32x2*)(ws + WS_AX);
        const float* const qkg = ARG_IN(4) + (size_t)l2 * 128;
        const int PITCH = nN * 256;
        const int nh = (even && colt == 512) ? 2 : 4;
        const int nit = (256 * nh) / 64;
        constexpr int U = 8;
#pragma unroll 1
        for (int it = 0; it < nit; it += U) {
            bf16* p[U]; int type[U]; v4u raw[U]; f32x4 tb[U][4];
#pragma unroll
            for (int k = 0; k < U; ++k) {
                const int hvi = (it + k) * 64 + gidx, rl = (nh == 2) ? (hvi >> 1) : (hvi >> 2), col = colt + 64 * ((nh == 2) ? (hvi & 1) : (hvi & 3)), row = u.pm * 256 + rl;
                const int ty = (even && colt == 512) ? 1 : 3;
                type[k] = ty; p[k] = QKV + (size_t)row * PITCH + col + 8 * sub;
                raw[k] = *(const v4u*)p[k];
                const int t = row < MP ? (row & 8191) : (row & 4095);
                const int aidx = (sub < 4) ? (t >> 6) : (t & 63);
                const f32x2* cs = (ty < 2) ? axT + aidx * 16 + 8 * (sub & 1) : ropeT + t * 8;
                tb[k][0] = *(const f32x4*)(cs); tb[k][1] = *(const f32x4*)(cs + 2); tb[k][2] = *(const f32x4*)(cs + 4); tb[k][3] = *(const f32x4*)(cs + 6);
            }
#pragma unroll
            for (int k = 0; k < U; ++k) *(v4u*)p[k] = prep_compute(raw[k], tb[k], type[k], sub, qkg);
        }
        asm volatile("s_waitcnt vmcnt(0)" ::: "memory");
    }
};

__global__ void __launch_bounds__(NWAVES * 64, 2) encoder_fwd(Args args) {
    extern __shared__ __attribute__((aligned(16))) unsigned char lds[];
    cg::grid_group grid = cg::this_grid();
    LAS unsigned char* const ldsb = (LAS unsigned char*)lds;
    if (threadIdx.x < 32) ((volatile LAS unsigned*)(ldsb + 131072 + 320))[threadIdx.x] = 0u;
    __syncthreads();
#define XBAR() do { XcdBarrier b_; b_.bar = (unsigned*)(ARG_WS() + WS_BAR); b_.x = xb_xcc_id(); b_.st = (volatile LAS unsigned*)(ldsb + 131072 + 320) + 8; xcd_barrier(b_); } while (0)
#define PHASE_IDS() int tid__ = threadIdx.x; asm volatile("" : "+v"(tid__)); const int lane = tid__ & 63; const int wave = __builtin_amdgcn_readfirstlane(tid__ >> 6); \
    int G__ = gridDim.x; asm volatile("" : "+s"(G__)); const int G = G__; const int bx__ = blockIdx.x; const int vcu = (G % 8 == 0) ? (bx__ % 8) * (G / 8) + bx__ / 8 : bx__; \
    const int gw = vcu * NWAVES + wave, NGW = G * NWAVES; (void)lane; (void)gw; (void)NGW; (void)wave

    {
        PHASE_IDS();
        if (blockIdx.x == 0) { unsigned* const bw = (unsigned*)(ARG_WS() + WS_BAR); for (int i = threadIdx.x; i < 4096; i += NWAVES * 64) __hip_atomic_store(bw + i, 0u, __ATOMIC_RELAXED, __HIP_MEMORY_SCOPE_AGENT); }
        LAS float* scr = (LAS float*)(ldsb + wave * 16384);
        unsigned char* const ws = ARG_WS(); bf16* const XB = (bf16*)(ws + WS_XB);
        f32x2* const ropeT = (f32x2*)(ws + WS_ROPE); f32x2* const axT = (f32x2*)(ws + WS_AX);
        bf16* const WinE = (bf16*)(ws + WS_WINE); bf16* const WoutE = (bf16*)(ws + WS_WOUTE); bf16* const WinO = (bf16*)(ws + WS_WINO); bf16* const WoutO = (bf16*)(ws + WS_WOUTO);
        bf16* const Wgu = (bf16*)(ws + WS_WGU); bf16* const Wdn = (bf16*)(ws + WS_WDN); bf16* const H = (bf16*)(ws + WS_H);
        constexpr int I_INE = 16 * 72, I_SQ = 16 * 32, I_INO = 16 * 48, I_GU = 16 * 176, I_DN = 44 * 32;
        constexpr int NITEMS = 2 * I_INE + 2 * I_SQ + 2 * I_INO + 2 * I_SQ + 4 * I_GU + 4 * I_DN;
        for (int it = gw; it < NITEMS; it += NGW) {
            int r = it;
            if (r < 2 * I_INE) { const int l = r / I_INE; r -= l * I_INE; transpose_item(ARG_IN(2) + (size_t)l * 1024 * EVEN_IN, 1024, EVEN_IN, WinE + (size_t)l * EVEN_IN * 1024, 0, scr, r, lane, ARG_IN(11) + (2 * l) * DMODEL); continue; } r -= 2 * I_INE;
            if (r < 2 * I_SQ) { const int l = r / I_SQ; r -= l * I_SQ; transpose_item(ARG_IN(3) + (size_t)l * 1024 * 1024, 1024, 1024, WoutE + (size_t)l * 1024 * 1024, 0, scr, r, lane, nullptr); continue; } r -= 2 * I_SQ;
            if (r < 2 * I_INO) { const int l = r / I_INO; r -= l * I_INO; transpose_item(ARG_IN(6) + (size_t)l * 1024 * ODD_IN, 1024, ODD_IN, WinO + (size_t)l * ODD_IN * 1024, 0, scr, r, lane, ARG_IN(11) + (2 * l + 1) * DMODEL); continue; } r -= 2 * I_INO;
            if (r < 2 * I_SQ) { const int l = r / I_SQ; r -= l * I_SQ; transpose_item(ARG_IN(7) + (size_t)l * 1024 * 1024, 1024, 1024, WoutO + (size_t)l * 1024 * 1024, 0, scr, r, lane, nullptr); continue; } r -= 2 * I_SQ;
            if (r < 4 * I_GU) { const int l = r / I_GU; r -= l * I_GU; transpose_item(ARG_IN(9) + (size_t)l * 1024 * GU, 1024, GU, Wgu + (size_t)l * GU * 1024, 1, scr, r, lane, ARG_IN(13) + l * DMODEL); continue; } r -= 4 * I_GU;
            { const int l = r / I_DN; r -= l * I_DN; transpose_item(ARG_IN(10) + (size_t)l * FFH * 1024, FFH, 1024, Wdn + (size_t)l * 1024 * FFH, 0, scr, r, lane, nullptr); }
        }
        for (int i = gw * 64 + lane; i < 8192 * 8 + 128 * 16; i += NGW * 64) {
            float ang;
            if (i < 65536) ang = (float)(i >> 3) * ROPE_INV[i & 7]; else ang = (float)((i - 65536) >> 4) * AX_INV[(i - 65536) & 15];
            const f32x2 cs = cossin(ang);
            if (i < 65536) ropeT[i] = cs; else axT[i - 65536] = cs;
        }
        const float* const xin0 = ARG_IN(0); const float* const xin1 = ARG_IN(1); float* const RS = (float*)(ws + WS_RS);
        for (int row = gw; row < MTOK; row += NGW) {
            const float* src = row < MP ? xin0 + (size_t)row * DMODEL : xin1 + (size_t)(row - MP) * DMODEL;
            f32x4 v[4]; float ss = 0.f;
#pragma unroll
            for (int j = 0; j < 4; ++j) { v[j] = *(const f32x4*)(src + 4 * lane + 256 * j); ss += (v[j].x * v[j].x + v[j].y * v[j].y) + (v[j].z * v[j].z + v[j].w * v[j].w); }
#pragma unroll
            for (int j = 0; j < 4; ++j) { v2u w; w.x = pk2(v[j].x, v[j].y); w.y = pk2(v[j].z, v[j].w); *(v2u*)(XB + (size_t)row * DMODEL + 4 * lane + 256 * j) = w; }
            const float r = __builtin_amdgcn_rsqf(wave_sum(ss, lane) * (1.f / DMODEL) + EPSN);
            if (lane == 0) RS[row] = r;
        }
    }
    grid.sync();
    { (void)xcd_barrier_post((unsigned*)(ARG_WS() + WS_BAR), (volatile LAS unsigned*)(ldsb + 131072 + 320) + 8); }

#pragma unroll 1
    for (int l = 0; l < 4; ++l) {
        const int l2 = l >> 1; const bool even = (l & 1) == 0;
        {
            const int NIN = even ? EVEN_IN : ODD_IN;
            unsigned char* const ws = ARG_WS(); const bf16* const H = (const bf16*)(ws + WS_XB); bf16* const QKV = (bf16*)(ws + WS_QKV); const float* const RS = (const float*)(ws + WS_RS);
            const bf16* const WinE = (const bf16*)(ws + WS_WINE); const bf16* const WinO = (const bf16*)(ws + WS_WINO);
            const bf16* Wt = even ? WinE + (size_t)l2 * EVEN_IN * 1024 : WinO + (size_t)l2 * ODD_IN * 1024;
            pg8::Gemm g{H, Wt, MTOK, NIN, 1024}; PrepOrder S; S.init(MTOK, NIN, (int)gridDim.x, (int)blockIdx.x); S.even = even ? 1 : 0; S.l2 = l2;
            pg8::EpiBf16<true> E{QKV, NIN, RS};
#ifndef NO_GEMM1
            pg8::gemm_phase<pg8::EpiBf16<true>, PrepOrder, PG8_ALIGN, PG8_SP2>(ldsb, g, S, E);
#endif
        }
        XBAR();
        if (even) {
            PHASE_IDS();
            unsigned char* const ws = ARG_WS(); bf16* const QKV = (bf16*)(ws + WS_QKV); bf16* const ATT = (bf16*)(ws + WS_ATT); bf16* const OB = (bf16*)(ws + WS_OB);
            const f32x2* const ropeT = (const f32x2*)(ws + WS_ROPE); const f32x2* const axT = (const f32x2*)(ws + WS_AX); const float* const qgainA = ARG_IN(4) + (size_t)l2 * 128;
#ifndef NO_ATT_E
#define DEC_E(u_, sb_, S_, h_, qb_) do { if ((u_) < 2048) { const int s_ = (u_) >> 8, rem_ = (u_) & 255; h_ = rem_ >> 5; qb_ = rem_ & 31; S_ = 8192; sb_ = s_ * 8192; } \
                else { const int u2_ = (u_) - 2048; const int s_ = u2_ >> 7, rem_ = u2_ & 127; h_ = rem_ >> 4; qb_ = rem_ & 15; S_ = 4096; sb_ = MP + s_ * 4096; } } while (0)
            { int b0 = 0; bool pre = false;
            for (int u = vcu; u < 2048 + 512; u += G) {
                int sb, S, vh, qb; DEC_E(u, sb, S, vh, qb);
                const int q0 = qb * 256;
                const attn_body::bf16 *nK = nullptr, *nV = nullptr;
                if (u + G < 2048 + 512) { int sbn, Sn, vhn, qbn; DEC_E(u + G, sbn, Sn, vhn, qbn); nK = (const attn_body::bf16*)(QKV + (size_t)sbn * EVEN_IN + 512 + 64 * (vhn >> 2)); nV = (const attn_body::bf16*)(QKV + (size_t)sbn * EVEN_IN + 640 + 64 * (vhn >> 2)); }
                attn_body::attn_unit<8, false, EVEN_IN, 1024, 64, 1>((const attn_body::bf16*)(QKV + (size_t)(sb + q0) * EVEN_IN + 64 * vh), (const attn_body::bf16*)(QKV + (size_t)sb * EVEN_IN + 512 + 64 * (vh >> 2)),
                    (const attn_body::bf16*)(QKV + (size_t)sb * EVEN_IN + 640 + 64 * (vh >> 2)), (attn_body::bf16*)(ATT + (size_t)(sb + q0) * 1024 + 64 * vh), q0, 0, S / 64, 0.f, (char*)lds, qgainA, (const float*)axT, b0, pre, nK, nV);
                b0 = (b0 + S / 64) % 3; pre = (nK != nullptr);
            } }
            { int b0 = 0; bool pre = false;
            const float lam_init = (l == 0) ? 0.2f : 0.4707130183435842f;
            float lam;
            { const float* lf = ARG_IN(5) + (size_t)l2 * 256;
              const float sa = wave_sum(lf[lane] * lf[64 + lane], lane), sb2 = wave_sum(lf[128 + lane] * lf[192 + lane], lane);
              lam = __builtin_bit_cast(float, __builtin_amdgcn_readfirstlane(__builtin_bit_cast(int, __expf(sa) - __expf(sb2) + lam_init))); }
#define DEC_P(p_, sb_, S_, h_, qb_) do { if ((p_) < 1024) { const int s_ = (p_) >> 7, rem_ = (p_) & 127; h_ = rem_ >> 5; qb_ = rem_ & 31; S_ = 8192; sb_ = s_ * 8192; } \
                else { const int p2_ = (p_) - 1024; const int s_ = p2_ >> 6, rem_ = p2_ & 63; h_ = rem_ >> 4; qb_ = rem_ & 15; S_ = 4096; sb_ = MP + s_ * 4096; } } while (0)
            for (int p = vcu; p < 1024 + 256; p += G) {
                int sb, S, h, qb; DEC_P(p, sb, S, h, qb);
                const int q0 = qb * 256;
                const attn_body::bf16 *pK = nullptr, *pV = nullptr;
                if (p + G < 1024 + 256) { int sbn, Sn, hn, qbn; DEC_P(p + G, sbn, Sn, hn, qbn); pK = (const attn_body::bf16*)(QKV + (size_t)sbn * EVEN_IN + 1280 + 128 * hn); pV = (const attn_body::bf16*)(QKV + (size_t)sbn * EVEN_IN + 1792 + 128 * hn); }
#pragma unroll 1
                for (int m = 0; m < 2; ++m) { const int hm = 2 * h + m;
                    const attn_body::bf16* nK = (m == 0) ? (const attn_body::bf16*)(QKV + (size_t)sb * EVEN_IN + 1280 + 64 * (hm + 1)) : pK;
                    const attn_body::bf16* nV = (m == 0) ? (const attn_body::bf16*)(QKV + (size_t)sb * EVEN_IN + 1792 + 128 * h) : pV;
                    attn_body::attn_unit<8, false, EVEN_IN, 1024, 128, 2>((const attn_body::bf16*)(QKV + (size_t)(sb + q0) * EVEN_IN + 768 + 64 * hm), (const attn_body::bf16*)(QKV + (size_t)sb * EVEN_IN + 1280 + 64 * hm),
                        (const attn_body::bf16*)(QKV + (size_t)sb * EVEN_IN + 1792 + 128 * h), (attn_body::bf16*)(OB + (size_t)(sb + q0) * 1024 + 128 * hm), q0, 0, S / 64, 0.f, (char*)lds, nullptr, (const float*)ropeT, b0, pre, nK, nV);
                    b0 = (b0 + S / 64) % 3; pre = (nK != nullptr); }
                asm volatile("s_waitcnt vmcnt(0)" ::: "memory");
                __builtin_amdgcn_s_barrier();
                asm volatile("" ::: "memory");
                int ct_ = threadIdx.x; asm volatile("" : "+v"(ct_));
                const int csub = ct_ & 15, crr = ct_ >> 4;
#pragma unroll 1
                for (int b4 = 0; b4 < 8; b4 += 4) {
                    v4u a[4], b[4];
#pragma unroll
                    for (int k = 0; k < 4; ++k) { const size_t row = (size_t)(sb + q0 + (b4 + k) * 32 + crr); const bf16* p0 = OB + row * 1024 + 256 * h + 8 * csub; a[k] = *(const v4u*)p0; b[k] = *(const v4u*)(p0 + 128); }
#pragma unroll
                    for (int k = 0; k < 4; ++k) { const size_t row = (size_t)(sb + q0 + (b4 + k) * 32 + crr);
                        float o[8] = {bflo(a[k].x) - lam * bflo(b[k].x), bfhi(a[k].x) - lam * bfhi(b[k].x), bflo(a[k].y) - lam * bflo(b[k].y), bfhi(a[k].y) - lam * bfhi(b[k].y),
                                      bflo(a[k].z) - lam * bflo(b[k].z), bfhi(a[k].z) - lam * bfhi(b[k].z), bflo(a[k].w) - lam * bflo(b[k].w), bfhi(a[k].w) - lam * bfhi(b[k].w)};
                        float ss = 0.f;
#pragma unroll
                        for (int i = 0; i < 8; ++i) ss += o[i] * o[i];
                        ss = sum16(ss);
                        const float r = __builtin_amdgcn_rsqf(ss * (1.f / 128.f) + EPSN) * (1.f - lam_init);
                        v4u w; w.x = pk2(o[0] * r, o[1] * r); w.y = pk2(o[2] * r, o[3] * r); w.z = pk2(o[4] * r, o[5] * r); w.w = pk2(o[6] * r, o[7] * r);
                        *(v4u*)(ATT + row * 1024 + 512 + 128 * h + 8 * csub) = w; }
                }
            } }
#undef DEC_P
#undef DEC_E
#endif
        } else {
            unsigned char* const ws = ARG_WS(); bf16* const QKV = (bf16*)(ws + WS_QKV); bf16* const ATT = (bf16*)(ws + WS_ATT); const float* const sinkp = ARG_IN(8) + l2 * 16; const f32x2* const ropeT = (const f32x2*)(ws + WS_ROPE);
            PHASE_IDS();
#define DEC_O(u_, sb_, S_, g_, q0_, klo_, khi_) do { int qb_; if ((u_) < 4096) { const int s_ = (u_) >> 9, rem_ = (u_) & 511; g_ = rem_ >> 7; qb_ = rem_ & 127; S_ = 8192; sb_ = s_ * 8192; } \
                else { const int u2_ = (u_) - 4096; const int s_ = u2_ >> 8, rem_ = u2_ & 255; g_ = rem_ >> 6; qb_ = rem_ & 63; S_ = 4096; sb_ = MP + s_ * 4096; } \
                q0_ = qb_ * 64; klo_ = q0_ >= 128 ? q0_ - 128 : 0; khi_ = (q0_ + 192 <= S_) ? q0_ + 192 : S_; \
                if (((khi_ - klo_) >> 6) & 1) { if (khi_ + 64 <= S_) khi_ += 64; else klo_ -= 64; } } while (0)
            { int b0 = 0; bool pre = false;
            for (int u = vcu; u < 4096 + 1024; u += G) {
                int sb, S, g, q0, klo, khi; DEC_O(u, sb, S, g, q0, klo, khi);
                const attn_body::bf16 *nK = nullptr, *nV = nullptr;
                if (u + G < 4096 + 1024) { int sbn, Sn, gn, q0n, klon, khin; DEC_O(u + G, sbn, Sn, gn, q0n, klon, khin);
                    nK = (const attn_body::bf16*)(QKV + (size_t)(sbn + klon) * ODD_IN + 1024 + 64 * gn); nV = (const attn_body::bf16*)(QKV + (size_t)(sbn + klon) * ODD_IN + 1280 + 64 * gn); }
#ifndef NO_ATT_O
                attn_body::attn_unit<8, true, ODD_IN, 1024, 64, 2>((const attn_body::bf16*)(QKV + (size_t)(sb + q0) * ODD_IN + 256 * g), (const attn_body::bf16*)(QKV + (size_t)sb * ODD_IN + 1024 + 64 * g),
                    (const attn_body::bf16*)(QKV + (size_t)sb * ODD_IN + 1280 + 64 * g), (attn_body::bf16*)(ATT + (size_t)(sb + q0) * 1024 + 256 * g), q0, klo >> 6, (khi - klo) >> 6, 0.f, (char*)lds, sinkp + 4 * g, (const float*)ropeT, b0, pre, nK, nV);
#endif
                b0 = (b0 + ((khi - klo) >> 6)) % 3; pre = (nK != nullptr);
            } }
#undef DEC_O
        }
        XBAR();
        {
            unsigned char* const ws = ARG_WS(); const bf16* const ATT = (const bf16*)(ws + WS_ATT); bf16* const MB = (bf16*)(ws + WS_OB);
            const bf16* Wt = (const bf16*)(ws + (even ? WS_WOUTE : WS_WOUTO)) + (size_t)l2 * 1024 * 1024;
            pg8::Gemm g{ATT, Wt, MTOK, 1024, 1024}; pg8::StaticOrder S; S.init(MTOK, 1024, (int)gridDim.x, (int)blockIdx.x);
            pg8::EpiBf16<false> E{MB, 1024, nullptr};
#ifndef NO_GEMM2
            pg8::gemm_phase<pg8::EpiBf16<false>, pg8::StaticOrder, PG8_ALIGN, PG8_SP2>(ldsb, g, S, E);
#endif
        }
        XBAR();
        {
            PHASE_IDS();
            unsigned char* const ws = ARG_WS(); bf16* const XB = (bf16*)(ws + WS_XB); const bf16* const MB = (const bf16*)(ws + WS_OB); float* const RS = (float*)(ws + WS_RS);
            const float* const gpost = ARG_IN(12) + l * DMODEL;
            rownorm_pass(lane, gw, NGW, XB, MB, gpost, RS, nullptr);
        }
        XBAR();
        {
            unsigned char* const ws = ARG_WS(); const bf16* const H = (const bf16*)(ws + WS_XB); bf16* const HID = (bf16*)(ws + WS_HID); const bf16* const Wgu = (const bf16*)(ws + WS_WGU); const float* const RS = (const float*)(ws + WS_RS);
            pg8::Gemm g{H, Wgu + (size_t)l * GU * 1024, MTOK, GU, 1024}; pg8::StaticOrder S; S.init(MTOK, GU, (int)gridDim.x, (int)blockIdx.x);
            pg8::EpiSwiGLU E{HID, FFH, RS};
#ifndef NO_GEMM3
            pg8::gemm_phase<pg8::EpiSwiGLU, pg8::StaticOrder, PG8_ALIGN, PG8_SP2>(ldsb, g, S, E);
#endif
        }
        XBAR();
        {
            unsigned char* const ws = ARG_WS(); const bf16* const HID = (const bf16*)(ws + WS_HID); bf16* const MB = (bf16*)(ws + WS_OB); const bf16* const Wdn = (const bf16*)(ws + WS_WDN);
            pg8::Gemm g{HID, Wdn + (size_t)l * 1024 * FFH, MTOK, 1024, FFH}; pg8::StaticOrder S; S.init(MTOK, 1024, (int)gridDim.x, (int)blockIdx.x);
            pg8::EpiBf16<false> E{MB, 1024, nullptr};
#ifndef NO_GEMM4
            pg8::gemm_phase<pg8::EpiBf16<false>, pg8::StaticOrder, PG8_ALIGN, PG8_SP2>(ldsb, g, S, E);
#endif
        }
        XBAR();
        {
            PHASE_IDS();
            unsigned char* const ws = ARG_WS(); bf16* const XB = (bf16*)(ws + WS_XB); const bf16* const MB = (const bf16*)(ws + WS_OB);
            float* const OUT = (l == 3) ? ARG_OUT() : nullptr; float* const RS = (l < 3) ? (float*)(ws + WS_RS) : nullptr;
            const float* const gpost = ARG_IN(14) + l * DMODEL;
            rownorm_pass(lane, gw, NGW, XB, MB, gpost, RS, OUT);
        }
        if (l < 3) XBAR();
    }
}

extern "C" void kernel_launch(void* const* d_in, const int* in_sizes, int n_in, void* d_out, int out_size, void* d_ws, size_t ws_size, hipStream_t stream) {
    static int grid = 0;
    if (grid == 0) {
        if (n_in != 15 || out_size != MTOK * DMODEL || ws_size < WS_END) { fprintf(stderr, "kernel_launch: unexpected shapes: n_in %d out %d ws %zu\n", n_in, out_size, ws_size); grid = -1; return; }
        int dev = 0, cus = 0, per_cu = 0;
        if (hipGetDevice(&dev) != hipSuccess || hipDeviceGetAttribute(&cus, hipDeviceAttributeMultiprocessorCount, dev) != hipSuccess) { grid = -1; return; }
        if (hipFuncSetAttribute((const void*)encoder_fwd, hipFuncAttributeMaxDynamicSharedMemorySize, LDS_BYTES) != hipSuccess) { fprintf(stderr, "kernel_launch: hipFuncSetAttribute failed\n"); grid = -1; return; }
        if (hipOccupancyMaxActiveBlocksPerMultiprocessor(&per_cu, (const void*)encoder_fwd, NWAVES * 64, LDS_BYTES) != hipSuccess || per_cu < 1) { fprintf(stderr, "kernel_launch: occupancy query says %d\n", per_cu); per_cu = 1; }
        (void)hipGetLastError();
        grid = cus;
    }
    if (grid < 0) return;
    Args a{};
    for (int i = 0; i < 15; ++i) a.in[i] = (const float*)d_in[i];
    a.out = (float*)d_out; a.ws = (unsigned char*)d_ws;
    void* kargs[] = {&a};
    const hipError_t e = hipLaunchCooperativeKernel((const void*)encoder_fwd, dim3(grid), dim3(NWAVES * 64), kargs, LDS_BYTES, stream);
    if (e != hipSuccess) fprintf(stderr, "kernel_launch: cooperative launch failed: %s (grid %d)\n", hipGetErrorString(e), grid);
}
```
